# Optimizing an MI355X kernel written in HIP

```python
import jax, jax.numpy as jnp
from jax import lax
import numpy as np

D_MODEL = 1024
BATCH = 2
SEQ = 8192
DEPTH = 1

CHUNK = 64
SUB_CHUNK = 16
N_SUB = CHUNK // SUB_CHUNK
N_MEM = 256
M_HEADS = 4
M_DK = 128
M_DV = 128
M_QK = M_HEADS * M_DK
M_WIDTH = M_HEADS * M_DV
CONV_W = 4
G_HEADS = 4
G_DK = 64
G_DV = 128
G_QK = G_HEADS * G_DK
G_WIDTH = G_HEADS * G_DV
G_RANK = 16
G_TAU = 16.0
MIX_WIDTH = M_WIDTH + G_WIDTH
X_HEADS = 4
X_DH = D_MODEL // X_HEADS
D_FF = 4 * D_MODEL
ALPHA = (2.0 * DEPTH) ** 0.25
BETA = (8.0 * DEPTH) ** -0.25
LN_EPS = 1e-5
IN_SIZES = (M_QK, M_QK, M_WIDTH, M_WIDTH, M_HEADS, M_HEADS, G_QK, G_QK, G_WIDTH, G_WIDTH, G_RANK)
IN_COLS = sum(IN_SIZES)
IN_SPLITS = tuple(int(s) for s in np.cumsum(IN_SIZES)[:-1])

kernel_name = "hymba_mlstm_gla_deepnorm_memxattn"


def layer_norm(x, g, b):
    xf = x.astype(jnp.float32)
    mu = jnp.mean(xf, -1, keepdims=True)
    var = jnp.mean(jnp.square(xf - mu), -1, keepdims=True)
    return ((xf - mu) * lax.rsqrt(var + LN_EPS) * g + b).astype(x.dtype)


def head_layer_norm(h, g):
    mu = jnp.mean(h, -1, keepdims=True)
    var = jnp.mean(jnp.square(h - mu), -1, keepdims=True)
    hn = (h - mu) * lax.rsqrt(var + LN_EPS)
    return hn.reshape(h.shape[0], h.shape[1], -1) * g


def head_rms_norm(h, g):
    hn = h * lax.rsqrt(jnp.mean(jnp.square(h), -1, keepdims=True) + LN_EPS)
    return hn.reshape(h.shape[0], h.shape[1], -1) * g


def causal_depthwise_conv(u, w, b):
    T = u.shape[1]
    up = jnp.pad(u, ((0, 0), (CONV_W - 1, 0), (0, 0)))
    return sum(up[:, j:j + T] * w[j] for j in range(CONV_W)) + b


def to_heads(u, n_heads):
    B_, T, C = u.shape
    return u.reshape(B_, T, n_heads, C // n_heads).transpose(0, 2, 1, 3)


def mlstm_chunkwise(q, k, v, i_pre, f_pre):
    B_, H, T, DK = q.shape
    DV = v.shape[-1]
    NC = T // CHUNK
    q = q.reshape(B_, H, NC, CHUNK, DK)
    k = k.reshape(B_, H, NC, CHUNK, DK) * (DK ** -0.5)
    v = v.reshape(B_, H, NC, CHUNK, DV)
    log_f = jax.nn.log_sigmoid(f_pre).reshape(B_, H, NC, CHUNK)
    log_i = i_pre.reshape(B_, H, NC, CHUNK)
    b = jnp.cumsum(log_f, -1)
    g = b[..., -1]
    a = g[..., None] - b + log_i
    a_max = jnp.max(a, -1)
    w = jnp.exp(a - a_max[..., None])
    U = jnp.einsum('bhcl,bhcld,bhcle->bhcde', w, k, v)
    u = jnp.einsum('bhcl,bhcld->bhcd', w, k)

    def step(carry, inp):
        C, n, m = carry
        U_c, u_c, g_c, am_c = inp
        m_new = jnp.maximum(g_c + m, am_c)
        dec = jnp.exp(g_c + m - m_new)
        inj = jnp.exp(am_c - m_new)
        C_new = dec[..., None, None] * C + inj[..., None, None] * U_c
        n_new = dec[..., None] * n + inj[..., None] * u_c
        return (C_new, n_new, m_new), (C, n, m)

    init = (jnp.zeros((B_, H, DK, DV), jnp.float32), jnp.zeros((B_, H, DK), jnp.float32),
            jnp.zeros((B_, H), jnp.float32))
    xs = (jnp.moveaxis(U, 2, 0), jnp.moveaxis(u, 2, 0), jnp.moveaxis(g, 2, 0), jnp.moveaxis(a_max, 2, 0))
    _, (C_prev, n_prev, m_prev) = lax.scan(step, init, xs)
    C_prev = jnp.moveaxis(C_prev, 0, 2)
    n_prev = jnp.moveaxis(n_prev, 0, 2)
    m_prev = jnp.moveaxis(m_prev, 0, 2)

    causal = jnp.tril(jnp.ones((CHUNK, CHUNK), bool))
    D = b[..., :, None] - b[..., None, :] + log_i[..., None, :]
    D = jnp.where(causal, D, -jnp.inf)
    inter = b + m_prev[..., None]
    m_t = jnp.maximum(inter, jnp.max(D, -1))
    Wts = jnp.exp(D - m_t[..., None])
    sc = jnp.exp(inter - m_t)
    S = jnp.einsum('bhcld,bhcsd->bhcls', q, k) * Wts
    num = (sc[..., None] * jnp.einsum('bhcld,bhcde->bhcle', q, C_prev)
           + jnp.einsum('bhcls,bhcse->bhcle', S, v))
    den = sc * jnp.einsum('bhcld,bhcd->bhcl', q, n_prev) + jnp.sum(S, -1)
    h = num / jnp.maximum(jnp.abs(den), jnp.exp(-m_t))[..., None]
    return h.reshape(B_, H, T, DV)


def gla_chunked(q, k, v, log_a):
    B_, H, T, DK = q.shape
    DV = v.shape[-1]
    NC = T // CHUNK
    shp = (B_, H, NC, N_SUB, SUB_CHUNK)
    q = q.reshape(*shp, DK) * (DK ** -0.5)
    k = k.reshape(*shp, DK)
    la = log_a.reshape(*shp, DK)
    bc = jnp.cumsum(la.reshape(B_, H, NC, CHUNK, DK), axis=3).reshape(*shp, DK)
    b_start = bc[..., :, :1, :] - la[..., :, :1, :]
    b_end = bc[..., :, -1, :]
    causal_s = jnp.tril(jnp.ones((SUB_CHUNK, SUB_CHUNK), bool))
    expo = bc[..., :, None, :] - bc[..., None, :, :]
    expo = jnp.where(causal_s[..., None], expo, -jnp.inf)
    a_diag = jnp.sum(q[..., :, None, :] * k[..., None, :, :] * jnp.exp(expo), -1)
    q_hat = q * jnp.exp(bc - b_start)
    k_hat = k * jnp.exp(b_end[..., :, None, :] - bc)
    mid = b_start[..., :, 0, :][..., :, None, :] - b_end[..., None, :, :]
    earlier = jnp.tril(jnp.ones((N_SUB, N_SUB), bool), -1)
    mid = jnp.exp(jnp.where(earlier[..., None], mid, -jnp.inf))
    a_off = jnp.einsum('bhcjtd,bhcjid,bhcisd->bhcjtis', q_hat, mid, k_hat)
    eye = jnp.eye(N_SUB, dtype=a_off.dtype)[:, None, :, None]
    A = (a_off + eye * a_diag[..., :, :, None, :]).reshape(B_, H, NC, CHUNK, CHUNK)
    vf = v.reshape(B_, H, NC, CHUNK, DV)
    o_intra = jnp.einsum('bhcts,bhcse->bhcte', A, vf)
    bcf = bc.reshape(B_, H, NC, CHUNK, DK)
    qf = q.reshape(B_, H, NC, CHUNK, DK)
    kf = k.reshape(B_, H, NC, CHUNK, DK)
    g = bcf[..., -1, :]
    U = jnp.einsum('bhcld,bhcle->bhcde', kf * jnp.exp(g[..., None, :] - bcf), vf)

    def step(S, inp):
        U_c, g_c = inp
        return jnp.exp(g_c)[..., None] * S + U_c, S

    _, S_prev = lax.scan(step, jnp.zeros((B_, H, DK, DV), jnp.float32),
                         (jnp.moveaxis(U, 2, 0), jnp.moveaxis(g, 2, 0)))
    S_prev = jnp.moveaxis(S_prev, 0, 2)
    o_inter = jnp.einsum('bhcld,bhcde->bhcle', qf * jnp.exp(bcf), S_prev)
    return (o_intra + o_inter).reshape(B_, H, T, DV)


def hybrid_mixer(x, w_in, conv_w, conv_b, m_i_bias, m_f_bias, m_norm_g, g_lr_w, g_lr_b, g_norm_g, w_out):
    proj = (x @ w_in).astype(jnp.float32)
    mq, mk, mv, mo, mi, mf, gq, gk, gv, gg, glr = jnp.split(proj, IN_SPLITS, axis=-1)
    qk = jax.nn.silu(causal_depthwise_conv(jnp.concatenate([mq, mk], -1),
                                           conv_w.astype(jnp.float32), conv_b.astype(jnp.float32)))
    mq, mk = jnp.split(qk, 2, axis=-1)
    i_pre = (mi + m_i_bias.astype(jnp.float32)).transpose(0, 2, 1)
    f_pre = (mf + m_f_bias.astype(jnp.float32)).transpose(0, 2, 1)
    hm = mlstm_chunkwise(to_heads(mq, M_HEADS), to_heads(mk, M_HEADS), to_heads(mv, M_HEADS), i_pre, f_pre)
    m_out = jax.nn.sigmoid(mo) * head_layer_norm(hm.transpose(0, 2, 1, 3), m_norm_g.astype(jnp.float32))
    log_a = jax.nn.log_sigmoid(glr @ g_lr_w.astype(jnp.float32) + g_lr_b.astype(jnp.float32)) / G_TAU
    hg = gla_chunked(to_heads(gq, G_HEADS), to_heads(gk, G_HEADS), to_heads(gv, G_HEADS), to_heads(log_a, G_HEADS))
    g_out = jax.nn.silu(gg) * head_rms_norm(hg.transpose(0, 2, 1, 3), g_norm_g.astype(jnp.float32))
    y = jnp.concatenate([m_out, g_out], -1).astype(x.dtype)
    return y @ w_out


def memory_cross_attention(x, mem, w_q, w_k, w_v, w_o):
    B_, T, _ = x.shape
    q = (x @ w_q).reshape(B_, T, X_HEADS, X_DH)
    k = (mem @ w_k).reshape(B_, N_MEM, X_HEADS, X_DH)
    v = (mem @ w_v).reshape(B_, N_MEM, X_HEADS, X_DH)
    s = jnp.einsum('bthd,bmhd->bhtm', q, k).astype(jnp.float32) * (X_DH ** -0.5)
    p = jax.nn.softmax(s, axis=-1).astype(v.dtype)
    o = jnp.einsum('bhtm,bmhd->bthd', p, v).reshape(B_, T, D_MODEL)
    return o @ w_o


def squared_relu_mlp(x, w_ff1, w_ff2):
    return jnp.square(jax.nn.relu(x @ w_ff1)) @ w_ff2


def setup_inputs(seed: int = 0) -> dict:
    key = jax.random.key(seed)
    ks = jax.random.split(key, 28)
    L = DEPTH

    def nrm(k, shape, scale):
        return jax.random.normal(k, shape, jnp.float32) * scale

    return {
        "x": nrm(ks[0], (BATCH, SEQ, D_MODEL), 1.0),
        "mem": nrm(ks[1], (BATCH, N_MEM, D_MODEL), 1.0),
        "ln_in_g": 1.0 + nrm(ks[2], (D_MODEL,), 0.02),
        "ln_in_b": nrm(ks[3], (D_MODEL,), 0.02),
        "w_in": nrm(ks[4], (L, D_MODEL, IN_COLS), D_MODEL ** -0.5),
        "conv_w": nrm(ks[5], (L, CONV_W, 2 * M_QK), CONV_W ** -0.5),
        "conv_b": nrm(ks[6], (L, 2 * M_QK), 0.02),
        "m_i_bias": nrm(ks[7], (L, M_HEADS), 0.1),
        "m_f_bias": jnp.linspace(3.0, 6.0, M_HEADS, dtype=jnp.float32)[None] + nrm(ks[8], (L, M_HEADS), 0.1),
        "m_norm_g": 1.0 + nrm(ks[9], (L, M_WIDTH), 0.02),
        "g_lr_w": nrm(ks[10], (L, G_RANK, G_QK), G_RANK ** -0.5),
        "g_lr_b": nrm(ks[11], (L, G_QK), 0.02),
        "g_norm_g": 1.0 + nrm(ks[12], (L, G_WIDTH), 0.02),
        "w_out": nrm(ks[13], (L, MIX_WIDTH, D_MODEL), MIX_WIDTH ** -0.5 * BETA),
        "ln1_g": 1.0 + nrm(ks[14], (L, D_MODEL), 0.02),
        "ln1_b": nrm(ks[15], (L, D_MODEL), 0.02),
        "x_wq": nrm(ks[16], (L, D_MODEL, D_MODEL), D_MODEL ** -0.5),
        "x_wk": nrm(ks[17], (L, D_MODEL, D_MODEL), D_MODEL ** -0.5),
        "x_wv": nrm(ks[18], (L, D_MODEL, D_MODEL), D_MODEL ** -0.5 * BETA),
        "x_wo": nrm(ks[19], (L, D_MODEL, D_MODEL), D_MODEL ** -0.5 * BETA),
        "ln2_g": 1.0 + nrm(ks[20], (L, D_MODEL), 0.02),
        "ln2_b": nrm(ks[21], (L, D_MODEL), 0.02),
        "w_ff1": nrm(ks[22], (L, D_MODEL, D_FF), D_MODEL ** -0.5 * BETA),
        "w_ff2": nrm(ks[23], (L, D_FF, D_MODEL), D_FF ** -0.5 * BETA),
        "ln3_g": 1.0 + nrm(ks[24], (L, D_MODEL), 0.02),
        "ln3_b": nrm(ks[25], (L, D_MODEL), 0.02),
    }


def reference(x, mem, ln_in_g, ln_in_b, w_in, conv_w, conv_b, m_i_bias, m_f_bias, m_norm_g,
              g_lr_w, g_lr_b, g_norm_g, w_out, ln1_g, ln1_b, x_wq, x_wk, x_wv, x_wo,
              ln2_g, ln2_b, w_ff1, w_ff2, ln3_g, ln3_b):
    h = layer_norm(x, ln_in_g, ln_in_b)
    for l in range(DEPTH):
        mix = hybrid_mixer(h, w_in[l], conv_w[l], conv_b[l], m_i_bias[l], m_f_bias[l], m_norm_g[l],
                           g_lr_w[l], g_lr_b[l], g_norm_g[l], w_out[l])
        h = layer_norm(ALPHA * h + mix, ln1_g[l], ln1_b[l])
        xa = memory_cross_attention(h, mem, x_wq[l], x_wk[l], x_wv[l], x_wo[l])
        h = layer_norm(ALPHA * h + xa, ln2_g[l], ln2_b[l])
        ff = squared_relu_mlp(h, w_ff1[l], w_ff2[l])
        h = layer_norm(ALPHA * h + ff, ln3_g[l], ln3_b[l])
    return h
```

```cpp
#include <hip/hip_runtime.h>
#include <hip/hip_cooperative_groups.h>
#include <cstdio>
#include <cstdint>
namespace cg = cooperative_groups;
namespace pg8 {
#define PG8_LAS __attribute__((address_space(3)))
typedef unsigned short bf16_t;
typedef short bf16x8 __attribute__((ext_vector_type(8)));
typedef float f32x4 __attribute__((ext_vector_type(4)));
typedef unsigned u32x4 __attribute__((ext_vector_type(4)));
constexpr int BM = 256, BK = 64, HALF = 128, HTB = HALF * BK * 2  , STAGE_BYTES = 8 * HTB, NXCD = 8, WGM = 8;

__host__ __device__ __forceinline__ int lds_byte(int r, int c) { const int st = (r >> 4) * 2 + (c >> 5), rr = r & 15, cc = c & 31, ob = rr * 64 + cc * 2; return st * 1024 + (ob ^ (((ob >> 9) & 1) << 5)); }
__host__ __device__ __forceinline__ void stage_rc(int b, int& R, int& C) { const int st = b / 1024, sb = b % 1024, swz = sb ^ (((sb >> 9) & 1) << 5); R = (st >> 1) * 16 + swz / 64; C = (st & 1) * 32 + (swz % 64) / 2; }
__host__ __device__ __forceinline__ int perm32(int rho) { const int n = rho >> 4, i = rho & 15; return 8 * (i >> 2) + 4 * n + (i & 3); }

struct Unit { int pm, pn; };
struct Gemm { const bf16_t* A; const bf16_t* Bt; int M, N, K; };

struct StaticOrder {
    int nM, nN, nwg, G, c;
    __host__ __device__ void init(int M, int N, int G_, int c_) { nM = M / BM; nN = N / BM; nwg = nM * nN; G = G_; c = c_; }
    __host__ __device__ bool next(int i, Unit& u) const {
        const long L = (long)i * G + c; if (L >= nwg) return false;
        int wgid = (int)L; { const int q = nwg / NXCD, r = nwg % NXCD, xcd = wgid % NXCD, off = wgid / NXCD; wgid = (xcd < r ? xcd * (q + 1) : r * (q + 1) + (xcd - r) * q) + off; }
        const int nig = WGM * nN, gid = wgid / nig, fm = gid * WGM, gsz = (nM - fm) < WGM ? (nM - fm) : WGM;
        u.pm = fm + ((wgid % nig) % gsz); u.pn = (wgid % nig) / gsz; return true;
    }
    __device__ __forceinline__ void a_ready(const Unit&) const {}
    __device__ __forceinline__ void done(const Unit&) const {}
};

__device__ __forceinline__ unsigned cvt_pk_bf16(float lo, float hi) { unsigned r; asm volatile("v_cvt_pk_bf16_f32 %0, %1, %2" : "=v"(r) : "v"(lo), "v"(hi)); return r; }
typedef float f32x2 __attribute__((ext_vector_type(2)));
__device__ __forceinline__ f32x2 gelu_pk(f32x2 v) {
    const f32x2 av = __builtin_elementwise_abs(v), d = av * 0.2316418882f + 1.0f;
    f32x2 t; t.x = __builtin_amdgcn_rcpf(d.x); t.y = __builtin_amdgcn_rcpf(d.y);
    f32x2 q = t * 0.5307027145f + (-0.7265760135f); q = q * t + 0.7107068705f; q = q * t + (-0.142248368f); q = q * t + 0.127414796f; q = q * t;
    const f32x2 s = (v * v) * (-0.72134752044f);
    f32x2 e; e.x = __builtin_amdgcn_exp2f(s.x); e.y = __builtin_amdgcn_exp2f(s.y);
    const f32x2 m = v * (q * e), r = v - m;
    f32x2 o; o.x = v.x < 0.f ? m.x : r.x; o.y = v.y < 0.f ? m.y : r.y; return o;
}

template <int ACT  > struct EpiBf16 {
    static constexpr bool PERM = true, AFTER_DRAIN = false; static_assert(ACT == 0 || ACT == 1, "EpiBf16: ACT is 0 (none) or 1 (gelu_pk)");
    bf16_t* O; int ldc; const float* bias; int split_cols; size_t split_stride; float scale0;
    __device__ __forceinline__ void operator()(const f32x4 (&acc)[2][2][4][2], const Unit& u, int wr, int wc, int fr, int fq) const {
        const int row0 = u.pm * BM + wr * 64 + fr; int colt = u.pn * BM; bf16_t* base = O;
        float sc = 1.f; if (split_cols) { const int t = colt / split_cols; base += (size_t)t * split_stride; colt -= t * split_cols; if (t == 0) sc = scale0; }
        const int col0 = colt + wc * 32 + 8 * fq, bcol0 = u.pn * BM + wc * 32 + 8 * fq;
        f32x4 bv[2][2];
#pragma unroll
        for (int bj = 0; bj < 2; ++bj)
#pragma unroll
            for (int n = 0; n < 2; ++n) bv[bj][n] = bias ? *(const f32x4*)(bias + bcol0 + bj * HALF + 4 * n) : (f32x4){0.f, 0.f, 0.f, 0.f};
#pragma unroll
        for (int ai = 0; ai < 2; ++ai)
#pragma unroll
            for (int m = 0; m < 4; ++m) { bf16_t* rowp = base + (size_t)(row0 + ai * HALF + m * 16) * ldc + col0;
#pragma unroll
                for (int bj = 0; bj < 2; ++bj) { f32x4 v0 = acc[ai][bj][m][0] + bv[bj][0], v1 = acc[ai][bj][m][1] + bv[bj][1];
                    if (ACT == 1) { f32x2 a = gelu_pk((f32x2){v0[0], v0[1]}), b = gelu_pk((f32x2){v0[2], v0[3]}), c = gelu_pk((f32x2){v1[0], v1[1]}), d = gelu_pk((f32x2){v1[2], v1[3]});
                        v0 = (f32x4){a.x, a.y, b.x, b.y}; v1 = (f32x4){c.x, c.y, d.x, d.y}; }
                    v0 = v0 * sc; v1 = v1 * sc; u32x4 w; w.x = cvt_pk_bf16(v0[0], v0[1]); w.y = cvt_pk_bf16(v0[2], v0[3]); w.z = cvt_pk_bf16(v1[0], v1[1]); w.w = cvt_pk_bf16(v1[2], v1[3]);
                    *(u32x4*)(rowp + bj * HALF) = w; } }
    }
};
template <class Epi, class Sched, bool ALIGN_EPI = false, bool SP2 = false>
__device__ __forceinline__ void gemm_phase(PG8_LAS unsigned char* lds, const Gemm g, const Sched& S, const Epi& E) {
    const int tid = threadIdx.x, wid = __builtin_amdgcn_readfirstlane(tid >> 6), lane = tid & 63, wr = wid >> 2, wc = wid & 3, fr = lane & 15, fq = lane >> 4;
    const int K = g.K, nt = K / BK;
    unsigned voffA[2], voffB[2];
#pragma unroll
    for (int i = 0; i < 2; ++i) { int R, C; stage_rc(tid * 16 + i * 8192, R, C); const int Rb = Epi::PERM ? ((R & ~31) + perm32(R & 31)) : R;
        voffA[i] = (unsigned)(R * K + C) * 2u; voffB[i] = (unsigned)(Rb * K + C) * 2u; }
    const size_t kstep = (size_t)(BK * 2);
    const size_t hstep = (size_t)HALF * K * 2;
    const size_t tstep = 2 * hstep;
    const unsigned ldsw = (unsigned)wid * 1024u;
    const int aoff = lds_byte(wr * 64 + fr, fq * 8), boff = lds_byte(wc * 32 + fr, fq * 8);
#define PG8_SA(b, h) (((b) * 2 + (h)) * HTB)
#define PG8_SB(b, h) ((4 + (b) * 2 + (h)) * HTB)
#define PG8_STAGE(bufoff, gbase, voff) do { _Pragma("unroll") for (int _i = 0; _i < 2; ++_i) \
        __builtin_amdgcn_global_load_lds((const unsigned*)((const char*)(gbase) + (voff)[_i]), (PG8_LAS unsigned*)(lds + (bufoff) + ldsw + _i * 8192), 16, 0, 0); } while (0)
#define PG8_LDA(dst, b, h) do { _Pragma("unroll") for (int m = 0; m < 4; ++m) _Pragma("unroll") for (int k = 0; k < 2; ++k) dst[m][k] = *(const PG8_LAS bf16x8*)(lds + PG8_SA(b, h) + aoff + m * 2048 + k * 1024); } while (0)
#define PG8_LDB(dst, b, h) do { _Pragma("unroll") for (int n = 0; n < 2; ++n) _Pragma("unroll") for (int k = 0; k < 2; ++k) dst[n][k] = *(const PG8_LAS bf16x8*)(lds + PG8_SB(b, h) + boff + n * 2048 + k * 1024); } while (0)
#define PG8_MMA(ai, bj, At, Bt) do { __builtin_amdgcn_s_setprio(1); _Pragma("unroll") for (int m = 0; m < 4; ++m) _Pragma("unroll") for (int n = 0; n < 2; ++n) _Pragma("unroll") for (int k = 0; k < 2; ++k) \
        acc[ai][bj][m][n] = __builtin_amdgcn_mfma_f32_16x16x32_bf16(Bt[n][k], At[m][k], acc[ai][bj][m][n], 0, 0, 0); __builtin_amdgcn_s_setprio(0); } while (0)
#define PG8_WAIT_V(n) asm volatile("s_waitcnt vmcnt(" #n ")" ::: "memory")
#define PG8_WAIT_L(n) asm volatile("s_waitcnt lgkmcnt(" #n ")" ::: "memory")
#define PG8_BAR __builtin_amdgcn_s_barrier()
#define PG8_SCHED __builtin_amdgcn_sched_barrier(0)
    Unit cur, nxt; int ui = 0;
    if (!S.next(0, cur)) return;
    f32x4 acc[2][2][4][2];
#pragma unroll
    for (int a = 0; a < 2; ++a)
#pragma unroll
        for (int b = 0; b < 2; ++b)
#pragma unroll
            for (int m = 0; m < 4; ++m)
#pragma unroll
                for (int n = 0; n < 2; ++n) acc[a][b][m][n] = (f32x4){0.f, 0.f, 0.f, 0.f};
    bf16x8 At[4][2], B0[2][2], B1[2][2];
    const char* cA = (const char*)g.A + (size_t)cur.pm * tstep; const char* cB = (const char*)g.Bt + (size_t)cur.pn * tstep;
    S.a_ready(cur);
    if constexpr (SP2) {
        PG8_STAGE(PG8_SB(0, 0), cB, voffB); PG8_STAGE(PG8_SB(0, 1), cB + hstep, voffB); PG8_STAGE(PG8_SA(0, 0), cA, voffA); PG8_STAGE(PG8_SA(0, 1), cA + hstep, voffA);
        if (wr == 1) PG8_BAR;
        PG8_WAIT_V(2); PG8_BAR;
        PG8_STAGE(PG8_SB(1, 0), cB + kstep, voffB); PG8_STAGE(PG8_SA(1, 0), cA + kstep, voffA); PG8_STAGE(PG8_SB(1, 1), cB + hstep + kstep, voffB);
        PG8_WAIT_V(6); PG8_BAR;
    } else {
        PG8_STAGE(PG8_SB(0, 0), cB, voffB); PG8_STAGE(PG8_SA(0, 0), cA, voffA); PG8_STAGE(PG8_SB(0, 1), cB + hstep, voffB); PG8_STAGE(PG8_SA(0, 1), cA + hstep, voffA);
        if (wr == 1) PG8_BAR;
        PG8_WAIT_V(4); PG8_BAR;
        PG8_STAGE(PG8_SB(1, 0), cB + kstep, voffB); PG8_STAGE(PG8_SA(1, 0), cA + kstep, voffA); PG8_STAGE(PG8_SB(1, 1), cB + hstep + kstep, voffB);
        PG8_WAIT_V(6); PG8_BAR;
    }
    for (;;) {
        const bool has_next = S.next(ui + 1, nxt);
        const char* nA = has_next ? (const char*)g.A + (size_t)nxt.pm * tstep : cA; const char* nB = has_next ? (const char*)g.Bt + (size_t)nxt.pn * tstep : cB;
        for (int t = 0; t < nt; t += 2) {
            const bool last = (t == nt - 2);
            const char* a1 = cA + (size_t)(t + 1) * kstep;
            const char* a2 = last ? nA : cA + (size_t)(t + 2) * kstep; const char* b2 = last ? nB : cB + (size_t)(t + 2) * kstep;
            const char* a3 = a2 + kstep; const char* b3 = b2 + kstep;
            if (last && has_next) S.a_ready(nxt);
            if constexpr (SP2) {
            PG8_LDB(B0, 0, 0); PG8_LDB(B1, 0, 1); PG8_SCHED; PG8_LDA(At, 0, 0); PG8_STAGE(PG8_SA(1, 1), a1 + hstep, voffA);
            PG8_WAIT_V(8); PG8_WAIT_L(0); PG8_BAR; PG8_MMA(0, 0, At, B0); PG8_MMA(0, 1, At, B1); PG8_BAR; PG8_SCHED;
            PG8_LDA(At, 0, 1); PG8_STAGE(PG8_SB(0, 0), b2, voffB); PG8_STAGE(PG8_SB(0, 1), b2 + hstep, voffB); PG8_STAGE(PG8_SA(0, 0), a2, voffA);
            PG8_WAIT_V(8); PG8_WAIT_L(0); PG8_BAR; PG8_MMA(1, 0, At, B0); PG8_MMA(1, 1, At, B1); PG8_BAR; PG8_SCHED;
            PG8_LDB(B0, 1, 0); PG8_LDB(B1, 1, 1); PG8_SCHED; PG8_LDA(At, 1, 0); PG8_STAGE(PG8_SA(0, 1), a2 + hstep, voffA);
            PG8_WAIT_V(8); PG8_WAIT_L(0); PG8_BAR; PG8_MMA(0, 0, At, B0); PG8_MMA(0, 1, At, B1); PG8_BAR; PG8_SCHED;
            PG8_LDA(At, 1, 1); PG8_STAGE(PG8_SB(1, 0), b3, voffB); PG8_STAGE(PG8_SB(1, 1), b3 + hstep, voffB); PG8_STAGE(PG8_SA(1, 0), a3, voffA);
            PG8_WAIT_V(8); PG8_WAIT_L(0); PG8_BAR; PG8_MMA(1, 0, At, B0); PG8_MMA(1, 1, At, B1); PG8_BAR; PG8_SCHED;
            } else {
            PG8_LDB(B0, 0, 0); PG8_SCHED; PG8_LDA(At, 0, 0); PG8_STAGE(PG8_SA(1, 1), a1 + hstep, voffA);
            PG8_WAIT_L(8); PG8_BAR; PG8_WAIT_L(0); PG8_MMA(0, 0, At, B0); PG8_BAR; PG8_SCHED;
            PG8_LDB(B1, 0, 1); PG8_STAGE(PG8_SB(0, 0), b2, voffB);
            PG8_BAR; PG8_WAIT_L(0); PG8_MMA(0, 1, At, B1); PG8_BAR;
            PG8_LDA(At, 0, 1); PG8_STAGE(PG8_SA(0, 0), a2, voffA);
            PG8_BAR; PG8_WAIT_L(0); PG8_MMA(1, 0, At, B0); PG8_BAR; PG8_SCHED;
            PG8_STAGE(PG8_SB(0, 1), b2 + hstep, voffB);
            PG8_WAIT_V(6); PG8_BAR; PG8_MMA(1, 1, At, B1); PG8_BAR;
            PG8_LDB(B0, 1, 0); PG8_SCHED; PG8_LDA(At, 1, 0); PG8_STAGE(PG8_SA(0, 1), a2 + hstep, voffA);
            PG8_WAIT_L(8); PG8_BAR; PG8_WAIT_L(0); PG8_MMA(0, 0, At, B0); PG8_BAR; PG8_SCHED;
            PG8_LDB(B1, 1, 1); PG8_STAGE(PG8_SB(1, 0), b3, voffB);
            PG8_BAR; PG8_WAIT_L(0); PG8_MMA(0, 1, At, B1); PG8_BAR;
            PG8_LDA(At, 1, 1); PG8_STAGE(PG8_SA(1, 0), a3, voffA);
            PG8_BAR; PG8_WAIT_L(0); PG8_MMA(1, 0, At, B0); PG8_BAR; PG8_SCHED;
            PG8_STAGE(PG8_SB(1, 1), b3 + hstep, voffB);
            PG8_WAIT_V(6); PG8_BAR; PG8_MMA(1, 1, At, B1); PG8_BAR;
            }
        }
        if constexpr (ALIGN_EPI) { if (wr == 0) PG8_BAR; }
        if constexpr (!Epi::AFTER_DRAIN) { E(acc, cur, wr, wc, fr, fq); S.done(cur); }
        if (!has_next) break;
#pragma unroll
        for (int a = 0; a < 2; ++a)
#pragma unroll
            for (int b = 0; b < 2; ++b)
#pragma unroll
                for (int m = 0; m < 4; ++m)
#pragma unroll
                    for (int n = 0; n < 2; ++n) acc[a][b][m][n] = (f32x4){0.f, 0.f, 0.f, 0.f};
        cur = nxt; cA = nA; cB = nB; ++ui;
        if constexpr (ALIGN_EPI) { if (wr == 1) PG8_BAR; }
    }
    PG8_WAIT_V(0);
    if constexpr (!ALIGN_EPI) { if (wr == 0) PG8_BAR; }
    PG8_BAR;
    if constexpr (Epi::AFTER_DRAIN) { E.fused(acc, cur, wr, wc, fr, fq, lds, wid, lane); S.done(cur); }
#undef PG8_SA
#undef PG8_SB
#undef PG8_STAGE
#undef PG8_LDA
#undef PG8_LDB
#undef PG8_MMA
#undef PG8_WAIT_V
#undef PG8_WAIT_L
#undef PG8_BAR
#undef PG8_SCHED
}
struct EpiResF32 {
    static constexpr bool PERM = false, AFTER_DRAIN = false;
    const float* res; float* out; int ldc; float alpha;
    __device__ __forceinline__ void operator()(const f32x4 (&acc)[2][2][4][2], const Unit& u, int wr, int wc, int fr, int fq) const {
        const int col0 = u.pn * BM + wc * 32 + 4 * fq;
#pragma unroll
        for (int ai = 0; ai < 2; ++ai)
#pragma unroll
            for (int m = 0; m < 4; ++m) { const size_t off = (size_t)(u.pm * BM + ai * HALF + wr * 64 + m * 16 + fr) * ldc + col0;
#pragma unroll
                for (int bj = 0; bj < 2; ++bj)
#pragma unroll
                    for (int n = 0; n < 2; ++n) { const f32x4 bs = *(const f32x4*)(res + off + bj * HALF + n * 16); *(f32x4*)(out + off + bj * HALF + n * 16) = bs * alpha + acc[ai][bj][m][n]; } }
    }
};
template <int ACT> struct EpiAct {
    static constexpr bool PERM = true, AFTER_DRAIN = false;
    bf16_t* O; int ldc; float scale;
    __device__ __forceinline__ void operator()(const f32x4 (&acc)[2][2][4][2], const Unit& u, int wr, int wc, int fr, int fq) const {
        const int row0 = u.pm * BM + wr * 64 + fr; const int col0 = u.pn * BM + wc * 32 + 8 * fq;
#pragma unroll
        for (int ai = 0; ai < 2; ++ai)
#pragma unroll
            for (int m = 0; m < 4; ++m) { bf16_t* rowp = O + (size_t)(row0 + ai * HALF + m * 16) * ldc + col0;
#pragma unroll
                for (int bj = 0; bj < 2; ++bj) { f32x4 v0 = acc[ai][bj][m][0], v1 = acc[ai][bj][m][1];
                    if (ACT == 2) {
#pragma unroll
                        for (int e = 0; e < 4; ++e) { float a = fmaxf(v0[e], 0.f), b = fmaxf(v1[e], 0.f); v0[e] = a * a; v1[e] = b * b; } }
                    else { v0 = v0 * scale; v1 = v1 * scale; }
                    u32x4 w; w.x = cvt_pk_bf16(v0[0], v0[1]); w.y = cvt_pk_bf16(v0[2], v0[3]); w.z = cvt_pk_bf16(v1[0], v1[1]); w.w = cvt_pk_bf16(v1[2], v1[3]);
                    *(u32x4*)(rowp + bj * HALF) = w; } }
    }
};
struct EpiProj {
    static constexpr bool PERM = true, AFTER_DRAIN = false;
    bf16_t* proj; float* gates; bf16_t* kb; bf16_t* vt;
    __device__ __forceinline__ void operator()(const f32x4 (&acc)[2][2][4][2], const Unit& u, int wr, int wc, int fr, int fq) const {
        bf16_t* base; int ldc, rowt, colt;
        if (u.pm < 64) {
            if (u.pn == 84) {
                if (wc == 0) {
#pragma unroll
                    for (int ai = 0; ai < 2; ++ai)
#pragma unroll
                        for (int m = 0; m < 4; ++m) { float* g = gates + (size_t)(u.pm * BM + ai * HALF + wr * 64 + m * 16 + fr) * 32 + 8 * fq;
                            *(f32x4*)g = acc[ai][0][m][0]; *(f32x4*)(g + 4) = acc[ai][0][m][1]; }
                }
                return;
            }
            base = proj; ldc = 3584; rowt = u.pm * BM; colt = (u.pn - 70) * BM;
        } else if (u.pm < 66) { base = kb; ldc = 1024; rowt = (u.pm - 64) * BM; colt = (u.pn - 85) * BM; }
        else { base = vt; ldc = 512; rowt = (u.pm - 66) * BM; colt = (u.pn - 64) * BM; }
        const int row0 = rowt + wr * 64 + fr; const int col0 = colt + wc * 32 + 8 * fq;
#pragma unroll
        for (int ai = 0; ai < 2; ++ai)
#pragma unroll
            for (int m = 0; m < 4; ++m) { bf16_t* rowp = base + (size_t)(row0 + ai * HALF + m * 16) * ldc + col0;
#pragma unroll
                for (int bj = 0; bj < 2; ++bj) { const f32x4 v0 = acc[ai][bj][m][0], v1 = acc[ai][bj][m][1];
                    u32x4 w; w.x = cvt_pk_bf16(v0[0], v0[1]); w.y = cvt_pk_bf16(v0[2], v0[3]); w.z = cvt_pk_bf16(v1[0], v1[1]); w.w = cvt_pk_bf16(v1[2], v1[3]);
                    *(u32x4*)(rowp + bj * HALF) = w; } }
    }
};
struct ProjOrder {
    StaticOrder so; int G, c;
    __host__ __device__ void init(int G_, int c_) { so.init(16384, 3840, G_, c_); G = G_; c = c_; }
    __host__ __device__ bool next(int i, Unit& u) const {
        const long L = (long)i * G + c;
        if (L < 960) { so.next(i, u); u.pn += 70; return true; }
        const int x = (int)(L - 960);
        if (x < 8) { u.pm = 64 + (x >> 2); u.pn = 85 + (x & 3); return true; }
        if (x < 16) { const int y = x - 8; u.pm = 66 + (y >> 1); u.pn = 64 + (y & 1); return true; }
        return false;
    }
    __device__ __forceinline__ void a_ready(const Unit&) const {}
    __device__ __forceinline__ void done(const Unit&) const {}
};
}

constexpr int NWAVES = 8, NTHREADS = 512;
constexpr int BATCH = 2, T = 8192, D = 1024, M = BATCH * T, FF = 4096, NMEM = 256;
constexpr int CH = 64, NC = T / CH;
constexpr int NPROJ = 3584;
constexpr int IN_COLS = 3608;
constexpr float LN_EPS = 1e-5f;
constexpr float ALPHA = 1.189207115002721f;
constexpr size_t MiB = 1u << 20;
constexpr size_t WS_CTL = 0;
constexpr size_t WS_ROWBUF = 2 * MiB;
constexpr size_t TILE_B = 256 * 1024 * 2;
constexpr size_t WS_XN = WS_ROWBUF, WS_MEMB = WS_ROWBUF + 64 * TILE_B, WS_WVT = WS_ROWBUF + 66 * TILE_B, WS_WINT = WS_ROWBUF + 70 * TILE_B, WS_WKT = WS_ROWBUF + 85 * TILE_B;
constexpr size_t WS_WOUT = 47 * MiB, WS_WQ = 49 * MiB, WS_WXO = 51 * MiB, WS_W1 = 53 * MiB, WS_W2 = 61 * MiB;
constexpr size_t WS_KB = 69 * MiB, WS_VT = 70 * MiB, WS_GATES = 71 * MiB, WS_STATS = 73 * MiB;
constexpr size_t WS_PROJ = 74 * MiB;
constexpr size_t WS_UM = 186 * MiB;
constexpr size_t WS_UG = 222 * MiB;
constexpr size_t WS_QB = 74 * MiB, WS_OB = 106 * MiB, WS_HB = 74 * MiB;
constexpr size_t WS_END = 238 * MiB;
static_assert(WS_ROWBUF + 89 * TILE_B <= WS_WOUT, "ws map");
constexpr int ST_SM = 0, ST_MPREV = 2048, ST_GDEC = 4096;

constexpr int LDS_BYTES = 147456;

#define LAS __attribute__((address_space(3)))
typedef unsigned short bf16;
typedef unsigned v4u __attribute__((ext_vector_type(4)));
typedef unsigned v2u __attribute__((ext_vector_type(2)));
typedef float f32x4 __attribute__((ext_vector_type(4)));
typedef short bf16x8 __attribute__((ext_vector_type(8)));

__device__ __forceinline__ unsigned f2bf(float f) { unsigned u = __builtin_bit_cast(unsigned, f); return (u + 0x7fffu + ((u >> 16) & 1u)) >> 16; }
__device__ __forceinline__ unsigned pk2(float lo, float hi) { return f2bf(lo) | (f2bf(hi) << 16); }
__device__ __forceinline__ float bflo(unsigned w) { return __builtin_bit_cast(float, w << 16); }
__device__ __forceinline__ float bfhi(unsigned w) { return __builtin_bit_cast(float, w & 0xffff0000u); }
__device__ __forceinline__ float bf1(bf16 h) { return __builtin_bit_cast(float, (unsigned)h << 16); }
__device__ __forceinline__ float sigmoidf_(float x) { return 1.f / (1.f + __expf(-x)); }
__device__ __forceinline__ float siluf_(float x) { return x / (1.f + __expf(-x)); }
__device__ __forceinline__ float logsigmoidf_(float x) { return fminf(x, 0.f) - log1pf(__expf(-fabsf(x))); }
__device__ __forceinline__ float wave_sum(float v) {
#pragma unroll
    for (int o = 1; o < 64; o <<= 1) v += __shfl_xor(v, o);
    return v;
}
__device__ __forceinline__ float wave_max(float v) {
#pragma unroll
    for (int o = 1; o < 64; o <<= 1) v = fmaxf(v, __shfl_xor(v, o));
    return v;
}
__device__ __forceinline__ float wave_incl_sum(float v, int lane) {
#pragma unroll
    for (int o = 1; o < 64; o <<= 1) { const float t = __shfl_up(v, o); if (lane >= o) v += t; }
    return v;
}
__device__ __forceinline__ float wave_incl_max(float v, int lane) {
#pragma unroll
    for (int o = 1; o < 64; o <<= 1) { const float t = __shfl_up(v, o); if (lane >= o) v = fmaxf(v, t); }
    return v;
}
#define MFMA16(a, b, c) __builtin_amdgcn_mfma_f32_16x16x32_bf16((a), (b), (c), 0, 0, 0)

struct Params {
    const float* in[26];
    float* out; unsigned char* ws;
};
enum { I_X = 0, I_MEM, I_LNIN_G, I_LNIN_B, I_WIN, I_CONVW, I_CONVB, I_MIB, I_MFB, I_MNG, I_GLRW, I_GLRB, I_GNG, I_WOUT, I_LN1G, I_LN1B, I_XWQ, I_XWK, I_XWV, I_XWO, I_LN2G, I_LN2B, I_WFF1, I_WFF2, I_LN3G, I_LN3B };

__device__ __forceinline__ void p0_transpose_item(const float* W, int ldw, int col0, int nblk, int K, bf16* WT, int row_off, LAS float* scr, int item, int lane) {
    const int kb = item / nblk, nb = item % nblk, k0 = 64 * kb, n0 = 32 * nb;
#pragma unroll 8
    for (int i = 0; i < 32; ++i) { const int kk = 2 * i + (lane >> 5); scr[kk * 33 + (lane & 31)] = W[(size_t)(k0 + kk) * ldw + col0 + n0 + (lane & 31)]; }
    asm volatile("s_waitcnt lgkmcnt(0)" ::: "memory");
    const int c = lane & 7;
#pragma unroll
    for (int j = 0; j < 4; ++j) { const int n = (lane >> 3) + 8 * j; const LAS float* s = scr + (8 * c) * 33 + n;
        v4u o; o.x = pk2(s[0 * 33], s[1 * 33]); o.y = pk2(s[2 * 33], s[3 * 33]); o.z = pk2(s[4 * 33], s[5 * 33]); o.w = pk2(s[6 * 33], s[7 * 33]);
        *(v4u*)(WT + (size_t)(row_off + n0 + n) * K + k0 + 8 * c) = o; }
    asm volatile("s_waitcnt lgkmcnt(0)" ::: "memory");
}
__device__ __forceinline__ void ln_row(const float* xrow, float* of, bf16* ob, const float* g, const float* b, int lane) {
    const f32x4* xr = (const f32x4*)xrow + lane;
    f32x4 v[4]; float s = 0.f;
#pragma unroll
    for (int j = 0; j < 4; ++j) { v[j] = xr[64 * j]; s += (v[j].x + v[j].y) + (v[j].z + v[j].w); }
    const float mean = wave_sum(s) * (1.f / D); float s2 = 0.f;
#pragma unroll
    for (int j = 0; j < 4; ++j) { v[j] = v[j] - mean; s2 += (v[j].x * v[j].x + v[j].y * v[j].y) + (v[j].z * v[j].z + v[j].w * v[j].w); }
    const float rstd = 1.f / sqrtf(wave_sum(s2) * (1.f / D) + LN_EPS);
#pragma unroll
    for (int j = 0; j < 4; ++j) {
        const f32x4 gv = ((const f32x4*)g)[lane + 64 * j], bv = ((const f32x4*)b)[lane + 64 * j];
        const f32x4 o = v[j] * rstd * gv + bv;
        if (of) ((f32x4*)of)[lane + 64 * j] = o;
        if (ob) ((unsigned long long*)ob)[lane + 64 * j] = (unsigned long long)pk2(o.x, o.y) | ((unsigned long long)pk2(o.z, o.w) << 32);
    }
}
__device__ __forceinline__ void ln_pass(const float* src, float* of, bf16* ob, const float* g, const float* b, int gw, int NGW, int lane) {
    for (int m = gw; m < M; m += NGW) ln_row(src + (size_t)m * D, of ? of + (size_t)m * D : nullptr, ob ? ob + (size_t)m * D : nullptr, g, b, lane);
}

__device__ __forceinline__ void p0_prologue(const Params& p, LAS unsigned char* lds, int gw, int NGW, int wave, int lane) {
    unsigned char* ws = p.ws;
    LAS float* scr = (LAS float*)(lds + wave * 16384);
    constexpr int I_IN1 = (D / 64) * (2048 / 32), I_IN2 = (D / 64) * (1536 / 32), I_DD = (D / 64) * (D / 32), I_F1 = (D / 64) * (FF / 32), I_F2 = (FF / 64) * (D / 32);
    constexpr int NITEMS = I_IN1 + I_IN2 + 5 * I_DD + I_F1 + I_F2;
    for (int it = gw; it < NITEMS; it += NGW) {
        int r = it;
        if (r < I_IN1) { p0_transpose_item(p.in[I_WIN], IN_COLS, 0, 2048 / 32, D, (bf16*)(ws + WS_WINT), 0, scr, r, lane); continue; } r -= I_IN1;
        if (r < I_IN2) { p0_transpose_item(p.in[I_WIN], IN_COLS, 2056, 1536 / 32, D, (bf16*)(ws + WS_WINT), 2048, scr, r, lane); continue; } r -= I_IN2;
        if (r < I_DD) { p0_transpose_item(p.in[I_WOUT], D, 0, D / 32, D, (bf16*)(ws + WS_WOUT), 0, scr, r, lane); continue; } r -= I_DD;
        if (r < I_DD) { p0_transpose_item(p.in[I_XWQ], D, 0, D / 32, D, (bf16*)(ws + WS_WQ), 0, scr, r, lane); continue; } r -= I_DD;
        if (r < I_DD) { p0_transpose_item(p.in[I_XWK], D, 0, D / 32, D, (bf16*)(ws + WS_WKT), 0, scr, r, lane); continue; } r -= I_DD;
        if (r < I_DD) { p0_transpose_item(p.in[I_XWV], D, 0, D / 32, D, (bf16*)(ws + WS_WVT), 0, scr, r, lane); continue; } r -= I_DD;
        if (r < I_DD) { p0_transpose_item(p.in[I_XWO], D, 0, D / 32, D, (bf16*)(ws + WS_WXO), 0, scr, r, lane); continue; } r -= I_DD;
        if (r < I_F1) { p0_transpose_item(p.in[I_WFF1], FF, 0, FF / 32, D, (bf16*)(ws + WS_W1), 0, scr, r, lane); continue; } r -= I_F1;
        p0_transpose_item(p.in[I_WFF2], D, 0, D / 32, FF, (bf16*)(ws + WS_W2), 0, scr, r, lane);
    }
    {
        bf16* wt = (bf16*)(ws + WS_WINT);
        const int gt = gw * 64 + lane, NGT = NGW * 64;
        for (int e = gt; e < 24 * D; e += NGT) { const int j = e / D, k = e % D; const int sc = j < 8 ? 2048 + j : 3592 + (j - 8);
            wt[(size_t)(3584 + j) * D + k] = (bf16)f2bf(p.in[I_WIN][(size_t)k * IN_COLS + sc]); }
        v4u z = {0u, 0u, 0u, 0u};
        for (int e = gt; e < 232 * D / 8; e += NGT) ((v4u*)(wt + (size_t)3608 * D))[e] = z;
        const float* mem = p.in[I_MEM]; bf16* mb = (bf16*)(ws + WS_MEMB);
        for (int e = gt; e < 512 * D / 4; e += NGT) { const f32x4 v = ((const f32x4*)mem)[e]; ((unsigned long long*)mb)[e] = (unsigned long long)pk2(v.x, v.y) | ((unsigned long long)pk2(v.z, v.w) << 32); }
    }
    ln_pass(p.in[I_X], p.out, (bf16*)(ws + WS_XN), p.in[I_LNIN_G], p.in[I_LNIN_B], gw, NGW, lane);
}
constexpr int KT_P = 72;
constexpr int TK_P = 136;
constexpr int TG_P = 72;
constexpr int HB_P = 132;

__device__ __forceinline__ void conv_silu_pair(const bf16* proj, const float* cw, const float* cb, int b, int c, int l0, int pcol, int ch, float (&o0)[8], float (&o1)[8]) {
    float x0[11], x1[11];
    const int t0 = c * CH + l0 - 3;
#pragma unroll
    for (int i = 0; i < 11; ++i) {
        const int t = t0 + i; unsigned w = 0u;
        if (t >= 0) w = *(const unsigned*)(proj + (size_t)(b * T + t) * NPROJ + pcol);
        x0[i] = bflo(w); x1[i] = bfhi(w);
    }
    float w0[4], w1[4];
#pragma unroll
    for (int j = 0; j < 4; ++j) { w0[j] = cw[j * 1024 + ch]; w1[j] = cw[j * 1024 + ch + 1]; }
    const float b0 = cb[ch], b1 = cb[ch + 1];
#pragma unroll
    for (int j = 0; j < 8; ++j) {
        float a0 = b0, a1 = b1;
#pragma unroll
        for (int k = 0; k < 4; ++k) { a0 += w0[k] * x0[j + k]; a1 += w1[k] * x1[j + k]; }
        o0[j] = siluf_(a0); o1[j] = siluf_(a1);
    }
}
__device__ __forceinline__ void stage_vT(const bf16* proj, size_t rowbase, int l0, int pcol, LAS bf16* img, int lane) {
    unsigned w[8];
#pragma unroll
    for (int j = 0; j < 8; ++j) w[j] = *(const unsigned*)(proj + (rowbase + l0 + j) * NPROJ + pcol + 2 * lane);
    v4u a, bq;
    a.x = (w[0] & 0xffffu) | (w[1] << 16); a.y = (w[2] & 0xffffu) | (w[3] << 16); a.z = (w[4] & 0xffffu) | (w[5] << 16); a.w = (w[6] & 0xffffu) | (w[7] << 16);
    bq.x = (w[0] >> 16) | (w[1] & 0xffff0000u); bq.y = (w[2] >> 16) | (w[3] & 0xffff0000u); bq.z = (w[4] >> 16) | (w[5] & 0xffff0000u); bq.w = (w[6] >> 16) | (w[7] & 0xffff0000u);
    *(LAS v4u*)(img + (2 * lane) * KT_P + l0) = a;
    *(LAS v4u*)(img + (2 * lane + 1) * KT_P + l0) = bq;
}
__device__ __forceinline__ v4u pack8(const float (&x)[8]) { v4u r; r.x = pk2(x[0], x[1]); r.y = pk2(x[2], x[3]); r.z = pk2(x[4], x[5]); r.w = pk2(x[6], x[7]); return r; }

__device__ __forceinline__ void mlstm_gates(const Params& p, size_t rowbase, int h, int lane, float& bcum, float& logi) {
    const float* gates = (const float*)(p.ws + WS_GATES);
    const float ipre = gates[(rowbase + lane) * 32 + h] + p.in[I_MIB][h];
    const float fpre = gates[(rowbase + lane) * 32 + 4 + h] + p.in[I_MFB][h];
    bcum = wave_incl_sum(logsigmoidf_(fpre), lane); logi = ipre;
}

__device__ __forceinline__ void p2_mlstm(const Params& p, LAS unsigned char* lds, int it, int wave, int lane) {
    const int c = it % NC, bh = it / NC, h = bh & 3, b = bh >> 2; const size_t rowbase = (size_t)b * T + (size_t)c * CH;
    const bf16* proj = (const bf16*)(p.ws + WS_PROJ);
    LAS bf16* kT = (LAS bf16*)lds;
    LAS bf16* vT = (LAS bf16*)(lds + 128 * KT_P * 2);
    float bcum, logi; mlstm_gates(p, rowbase, h, lane, bcum, logi);
    const float g = __shfl(bcum, 63);
    const float a = g - bcum + logi; const float amax = wave_max(a); const float wl = __expf(a - amax);
    if (wave == 0 && lane == 0) { float* sm = (float*)(p.ws + WS_STATS) + ST_SM + 2 * it; sm[0] = g; sm[1] = amax; }
    const int l0 = wave * 8;
    float k0[8], k1[8];
    conv_silu_pair(proj, p.in[I_CONVW], p.in[I_CONVB], b, c, l0, 512 + h * 128 + 2 * lane, 512 + h * 128 + 2 * lane, k0, k1);
#pragma unroll
    for (int j = 0; j < 8; ++j) { const float s = __shfl(wl, l0 + j) * 0.08838834764831845f; k0[j] *= s; k1[j] *= s; }
    *(LAS v4u*)(kT + (2 * lane) * KT_P + l0) = pack8(k0);
    *(LAS v4u*)(kT + (2 * lane + 1) * KT_P + l0) = pack8(k1);
    stage_vT(proj, rowbase, l0, 1024 + h * 128, vT, lane);
    for (int idx = wave * 64 + lane; idx < 16 * 64; idx += NTHREADS) { const int e = 128 + (idx >> 6), l = idx & 63; vT[e * KT_P + l] = (e == 128) ? (bf16)0x3F80 : (bf16)0; }
    __syncthreads();
    const int r = lane & 15, q = lane >> 4, d0 = wave * 16;
    bf16x8 af[2];
#pragma unroll
    for (int kk = 0; kk < 2; ++kk) af[kk] = *(const LAS bf16x8*)(kT + (d0 + r) * KT_P + kk * 32 + q * 8);
    bf16* um = (bf16*)(p.ws + WS_UM) + (size_t)it * (144 * 128);
#pragma unroll
    for (int et = 0; et < 9; ++et) {
        f32x4 acc = {0.f, 0.f, 0.f, 0.f};
#pragma unroll
        for (int kk = 0; kk < 2; ++kk) { const bf16x8 bf = *(const LAS bf16x8*)(vT + (et * 16 + r) * KT_P + kk * 32 + q * 8); acc = MFMA16(af[kk], bf, acc); }
        v2u o; o.x = pk2(acc[0], acc[1]); o.y = pk2(acc[2], acc[3]);
        *(v2u*)(um + (size_t)(et * 16 + r) * 128 + d0 + q * 4) = o;
    }
    __syncthreads();
}

__device__ __forceinline__ void gla_decay(const Params& p, size_t rowbase, int h, int wave, int lane, LAS float* tot, float (&bc)[8], float& gtot) {
    const float* gates = (const float*)(p.ws + WS_GATES);
    float wr[16];
#pragma unroll
    for (int r = 0; r < 16; ++r) wr[r] = p.in[I_GLRW][r * 256 + h * 64 + lane];
    const float bias = p.in[I_GLRB][h * 64 + lane];
    float run = 0.f;
#pragma unroll
    for (int j = 0; j < 8; ++j) {
        const float* gl = gates + (rowbase + wave * 8 + j) * 32 + 8;
        float z = bias;
#pragma unroll
        for (int r = 0; r < 16; ++r) z += gl[r] * wr[r];
        run += logsigmoidf_(z) * (1.f / 16.f); bc[j] = run;
    }
    tot[wave * 64 + lane] = run;
    __syncthreads();
    float pre = 0.f, all = 0.f;
#pragma unroll
    for (int w = 0; w < 8; ++w) { const float t = tot[w * 64 + lane]; all += t; if (w < wave) pre += t; }
#pragma unroll
    for (int j = 0; j < 8; ++j) bc[j] += pre;
    gtot = all;
}

__device__ __forceinline__ void p2_gla(const Params& p, LAS unsigned char* lds, int it, int wave, int lane) {
    const int c = it % NC, bh = it / NC, h = bh & 3, b = bh >> 2; const size_t rowbase = (size_t)b * T + (size_t)c * CH;
    const bf16* proj = (const bf16*)(p.ws + WS_PROJ);
    LAS bf16* kT = (LAS bf16*)lds;
    LAS bf16* vT = (LAS bf16*)(lds + 64 * KT_P * 2);
    LAS float* tot = (LAS float*)(lds + 64 * KT_P * 2 + 128 * KT_P * 2);
    LAS float* gl = tot + 512;
    float bc[8], gtot; gla_decay(p, rowbase, h, wave, lane, tot, bc, gtot);
    const int l0 = wave * 8;
    float kk_[8];
#pragma unroll
    for (int j = 0; j < 8; ++j) kk_[j] = bf1(proj[(rowbase + l0 + j) * NPROJ + 2304 + h * 64 + lane]) * __expf(-bc[j]);
    *(LAS v4u*)(kT + lane * KT_P + l0) = pack8(kk_);
    stage_vT(proj, rowbase, l0, 2560 + h * 128, vT, lane);
    if (wave == 0) { gl[lane] = gtot; ((float*)(p.ws + WS_STATS))[ST_GDEC + it * 64 + lane] = gtot; }
    __syncthreads();
    const int r = lane & 15, q = lane >> 4, d0 = (wave & 3) * 16, e0 = (wave >> 2) * 64;
    bf16x8 af[2];
#pragma unroll
    for (int kk = 0; kk < 2; ++kk) af[kk] = *(const LAS bf16x8*)(kT + (d0 + r) * KT_P + kk * 32 + q * 8);
    float eg[4];
#pragma unroll
    for (int j = 0; j < 4; ++j) eg[j] = __expf(gl[d0 + q * 4 + j]);
    bf16* ug = (bf16*)(p.ws + WS_UG) + (size_t)it * (128 * 64);
#pragma unroll
    for (int et = 0; et < 4; ++et) {
        f32x4 acc = {0.f, 0.f, 0.f, 0.f};
#pragma unroll
        for (int kk = 0; kk < 2; ++kk) { const bf16x8 bf = *(const LAS bf16x8*)(vT + (e0 + et * 16 + r) * KT_P + kk * 32 + q * 8); acc = MFMA16(af[kk], bf, acc); }
        v2u o; o.x = pk2(acc[0] * eg[0], acc[1] * eg[1]); o.y = pk2(acc[2] * eg[2], acc[3] * eg[3]);
        *(v2u*)(ug + (size_t)(e0 + et * 16 + r) * 64 + d0 + q * 4) = o;
    }
    __syncthreads();
}

__device__ __forceinline__ void p3_scan(const Params& p, int gw, int NGW, int lane) {
    float* st = (float*)(p.ws + WS_STATS);
    for (int wi = gw; wi < 8 * 129 + 8 * 64; wi += NGW) {
        if (wi < 8 * 129) {
            const int bh = wi / 129, row = wi % 129;
            unsigned* base = (unsigned*)((bf16*)(p.ws + WS_UM) + ((size_t)bh * NC * 144 + row) * 128) + lane;
            const size_t cstep = 144 * 128 / 2;
            float c0 = 0.f, c1 = 0.f, m = 0.f;
            for (int cb = 0; cb < NC; cb += 8) {
                unsigned u[8];
#pragma unroll
                for (int j = 0; j < 8; ++j) u[j] = base[(size_t)(cb + j) * cstep];
#pragma unroll
                for (int j = 0; j < 8; ++j) {
                    const int c = cb + j;
                    const float g = st[ST_SM + 2 * (bh * NC + c)], am = st[ST_SM + 2 * (bh * NC + c) + 1];
                    base[(size_t)c * cstep] = pk2(c0, c1);
                    if (row == 0 && lane == 0) st[ST_MPREV + bh * NC + c] = m;
                    const float mn = fmaxf(g + m, am), dec = __expf(g + m - mn), inj = __expf(am - mn);
                    c0 = dec * c0 + inj * bflo(u[j]); c1 = dec * c1 + inj * bfhi(u[j]); m = mn;
                }
            }
        } else {
            const int w2 = wi - 8 * 129, bh = w2 >> 6, rp = w2 & 63;
            unsigned* base = (unsigned*)((bf16*)(p.ws + WS_UG) + ((size_t)bh * NC * 128 + 2 * rp) * 64) + lane;
            const size_t cstep = 128 * 64 / 2;
            const int d = (2 * lane) & 63;
            float c0 = 0.f, c1 = 0.f;
            for (int cb = 0; cb < NC; cb += 8) {
                unsigned u[8];
#pragma unroll
                for (int j = 0; j < 8; ++j) u[j] = base[(size_t)(cb + j) * cstep];
#pragma unroll
                for (int j = 0; j < 8; ++j) {
                    const int c = cb + j;
                    const float g0 = st[ST_GDEC + (bh * NC + c) * 64 + d], g1 = st[ST_GDEC + (bh * NC + c) * 64 + d + 1];
                    base[(size_t)c * cstep] = pk2(c0, c1);
                    c0 = __expf(g0) * c0 + bflo(u[j]); c1 = __expf(g1) * c1 + bfhi(u[j]);
                }
            }
        }
    }
}
__device__ __forceinline__ void p4_mlstm(const Params& p, LAS unsigned char* lds, int it, int wave, int lane) {
    const int c = it % NC, bh = it / NC, h = bh & 3, b = bh >> 2; const size_t rowbase = (size_t)b * T + (size_t)c * CH;
    const bf16* proj = (const bf16*)(p.ws + WS_PROJ);
    LAS bf16* qs = (LAS bf16*)lds;
    LAS bf16* ks = (LAS bf16*)(lds + 17408);
    LAS bf16* vT = (LAS bf16*)(lds + 34816);
    LAS bf16* Ss = (LAS bf16*)(lds + 53248);
    LAS float* hb = (LAS float*)(lds + 62464);
    LAS float* fl = (LAS float*)(lds + 96256);
    LAS float* li_s = fl, *mm_s = fl + 64, *sc_s = fl + 128, *emt_s = fl + 192, *denp = fl + 256, *deni = fl + 512;
    const int tid = wave * 64 + lane;
    {
        float bcum, logi; mlstm_gates(p, rowbase, h, lane, bcum, logi);
        const float li = logi - bcum; const float mrun = wave_incl_max(li, lane);
        const float mprev = ((const float*)(p.ws + WS_STATS))[ST_MPREV + it];
        const float mm = fmaxf(mprev, mrun);
        if (wave == 0) { li_s[lane] = li; mm_s[lane] = mm; sc_s[lane] = __expf(mprev - mm); emt_s[lane] = __expf(-(bcum + mm)); }
    }
    const int l0 = wave * 8;
    {
        float a0[8], a1[8];
        conv_silu_pair(proj, p.in[I_CONVW], p.in[I_CONVB], b, c, l0, h * 128 + 2 * lane, h * 128 + 2 * lane, a0, a1);
#pragma unroll
        for (int j = 0; j < 8; ++j) *(LAS unsigned*)(qs + (l0 + j) * TK_P + 2 * lane) = pk2(a0[j], a1[j]);
        conv_silu_pair(proj, p.in[I_CONVW], p.in[I_CONVB], b, c, l0, 512 + h * 128 + 2 * lane, 512 + h * 128 + 2 * lane, a0, a1);
#pragma unroll
        for (int j = 0; j < 8; ++j) *(LAS unsigned*)(ks + (l0 + j) * TK_P + 2 * lane) = pk2(a0[j] * 0.08838834764831845f, a1[j] * 0.08838834764831845f);
    }
    stage_vT(proj, rowbase, l0, 1024 + h * 128, vT, lane);
    __syncthreads();
    const int r = lane & 15, q = lane >> 4;
    {
        const int lt = wave >> 1;
        bf16x8 af[4];
#pragma unroll
        for (int kk = 0; kk < 4; ++kk) af[kk] = *(const LAS bf16x8*)(qs + (lt * 16 + r) * TK_P + kk * 32 + q * 8);
#pragma unroll
        for (int si = 0; si < 2; ++si) {
            const int st = 2 * (wave & 1) + si;
            f32x4 acc = {0.f, 0.f, 0.f, 0.f};
            if (st <= lt) {
#pragma unroll
                for (int kk = 0; kk < 4; ++kk) { const bf16x8 bf = *(const LAS bf16x8*)(ks + (st * 16 + r) * TK_P + kk * 32 + q * 8); acc = MFMA16(af[kk], bf, acc); }
            }
            const int s = st * 16 + r; const float lis = li_s[s];
#pragma unroll
            for (int j = 0; j < 4; ++j) {
                const int l = lt * 16 + q * 4 + j;
                float v = (s <= l) ? acc[j] * __expf(lis - mm_s[l]) : 0.f;
                Ss[l * KT_P + s] = (bf16)f2bf(v);
                v += __shfl_xor(v, 1); v += __shfl_xor(v, 2); v += __shfl_xor(v, 4); v += __shfl_xor(v, 8);
                if (r == 0) denp[st * 64 + l] = v;
            }
        }
    }
    __syncthreads();
    const int lt = wave & 3, eh = wave >> 2;
    f32x4 acc1[4], acc2[4], accd = {0.f, 0.f, 0.f, 0.f};
    {
        const bf16* ct = (const bf16*)(p.ws + WS_UM) + (size_t)it * (144 * 128);
        bf16x8 aq[4], as_[2];
#pragma unroll
        for (int kk = 0; kk < 4; ++kk) aq[kk] = *(const LAS bf16x8*)(qs + (lt * 16 + r) * TK_P + kk * 32 + q * 8);
#pragma unroll
        for (int kk = 0; kk < 2; ++kk) as_[kk] = *(const LAS bf16x8*)(Ss + (lt * 16 + r) * KT_P + kk * 32 + q * 8);
#pragma unroll
        for (int et = 0; et < 4; ++et) {
            const int e = (eh * 4 + et) * 16 + r;
            acc1[et] = (f32x4){0.f, 0.f, 0.f, 0.f}; acc2[et] = (f32x4){0.f, 0.f, 0.f, 0.f};
#pragma unroll
            for (int kk = 0; kk < 2; ++kk) { const bf16x8 bf = *(const LAS bf16x8*)(vT + e * KT_P + kk * 32 + q * 8); acc1[et] = MFMA16(as_[kk], bf, acc1[et]); }
#pragma unroll
            for (int kk = 0; kk < 4; ++kk) { const bf16x8 bf = *(const bf16x8*)(ct + (size_t)e * 128 + kk * 32 + q * 8); acc2[et] = MFMA16(aq[kk], bf, acc2[et]); }
        }
        if (eh == 0) {
#pragma unroll
            for (int kk = 0; kk < 4; ++kk) { const bf16x8 bf = *(const bf16x8*)(ct + (size_t)(128 + r) * 128 + kk * 32 + q * 8); accd = MFMA16(aq[kk], bf, accd); }
            if (r == 0) {
#pragma unroll
                for (int j = 0; j < 4; ++j) { const int l = lt * 16 + q * 4 + j; deni[l] = sc_s[l] * accd[j]; }
            }
        }
    }
    __syncthreads();
#pragma unroll
    for (int j = 0; j < 4; ++j) {
        const int l = lt * 16 + q * 4 + j;
        const float den = ((denp[l] + denp[64 + l]) + (denp[128 + l] + denp[192 + l])) + deni[l];
        const float inv = 1.f / fmaxf(fabsf(den), emt_s[l]); const float sc = sc_s[l];
#pragma unroll
        for (int et = 0; et < 4; ++et) hb[l * HB_P + (eh * 4 + et) * 16 + r] = (acc1[et][j] + sc * acc2[et][j]) * inv;
    }
    __syncthreads();
    {
        const int l = tid >> 3, ck = tid & 7, e0 = ck * 16;
        f32x4 x[4]; float s = 0.f;
#pragma unroll
        for (int i = 0; i < 4; ++i) { x[i] = *(const LAS f32x4*)(hb + l * HB_P + e0 + 4 * i); s += (x[i].x + x[i].y) + (x[i].z + x[i].w); }
        s += __shfl_xor(s, 1); s += __shfl_xor(s, 2); s += __shfl_xor(s, 4);
        const float mean = s * (1.f / 128.f); float s2 = 0.f;
#pragma unroll
        for (int i = 0; i < 4; ++i) { x[i] = x[i] - mean; s2 += (x[i].x * x[i].x + x[i].y * x[i].y) + (x[i].z * x[i].z + x[i].w * x[i].w); }
        s2 += __shfl_xor(s2, 1); s2 += __shfl_xor(s2, 2); s2 += __shfl_xor(s2, 4);
        const float rstd = 1.f / sqrtf(s2 * (1.f / 128.f) + LN_EPS);
        const bf16* mo = proj + (rowbase + l) * NPROJ + 1536 + h * 128 + e0;
        const v4u m0 = *(const v4u*)mo, m1 = *(const v4u*)(mo + 8);
        const float* gn = p.in[I_MNG] + h * 128 + e0;
        const unsigned mw[8] = {m0.x, m0.y, m0.z, m0.w, m1.x, m1.y, m1.z, m1.w};
        unsigned ow[8];
#pragma unroll
        for (int i = 0; i < 8; ++i) {
            const float xa = x[i >> 1][(i & 1) * 2], xb = x[i >> 1][(i & 1) * 2 + 1];
            const float ya = sigmoidf_(bflo(mw[i])) * xa * rstd * gn[2 * i], yb = sigmoidf_(bfhi(mw[i])) * xb * rstd * gn[2 * i + 1];
            ow[i] = pk2(ya, yb);
        }
        bf16* y = (bf16*)(p.ws + WS_XN) + (rowbase + l) * D + h * 128 + e0;
        *(v4u*)y = (v4u){ow[0], ow[1], ow[2], ow[3]}; *(v4u*)(y + 8) = (v4u){ow[4], ow[5], ow[6], ow[7]};
    }
    __syncthreads();
}

__device__ __forceinline__ void p4_gla(const Params& p, LAS unsigned char* lds, int it, int wave, int lane) {
    const int c = it % NC, bh = it / NC, h = bh & 3, b = bh >> 2; const size_t rowbase = (size_t)b * T + (size_t)c * CH;
    const bf16* proj = (const bf16*)(p.ws + WS_PROJ);
    LAS bf16* qs = (LAS bf16*)lds;
    LAS bf16* ks = (LAS bf16*)(lds + 9216);
    LAS bf16* vT = (LAS bf16*)(lds + 18432);
    LAS bf16* As = (LAS bf16*)(lds + 36864);
    LAS float* hb = (LAS float*)(lds + 46080);
    LAS float* tot = (LAS float*)(lds + 79872);
    const int tid = wave * 64 + lane;
    float bc[8], gtot; gla_decay(p, rowbase, h, wave, lane, tot, bc, gtot);
    const int l0 = wave * 8;
#pragma unroll
    for (int j = 0; j < 8; ++j) {
        const size_t ro = (rowbase + l0 + j) * NPROJ;
        const float qv = bf1(proj[ro + 2048 + h * 64 + lane]) * __expf(bc[j]) * 0.125f;
        const float kv = bf1(proj[ro + 2304 + h * 64 + lane]) * __expf(-bc[j]);
        qs[(l0 + j) * TG_P + lane] = (bf16)f2bf(qv); ks[(l0 + j) * TG_P + lane] = (bf16)f2bf(kv);
    }
    stage_vT(proj, rowbase, l0, 2560 + h * 128, vT, lane);
    __syncthreads();
    const int r = lane & 15, q = lane >> 4;
    {
        const int lt = wave >> 1;
        bf16x8 af[2];
#pragma unroll
        for (int kk = 0; kk < 2; ++kk) af[kk] = *(const LAS bf16x8*)(qs + (lt * 16 + r) * TG_P + kk * 32 + q * 8);
#pragma unroll
        for (int si = 0; si < 2; ++si) {
            const int st = 2 * (wave & 1) + si;
            f32x4 acc = {0.f, 0.f, 0.f, 0.f};
            if (st <= lt) {
#pragma unroll
                for (int kk = 0; kk < 2; ++kk) { const bf16x8 bf = *(const LAS bf16x8*)(ks + (st * 16 + r) * TG_P + kk * 32 + q * 8); acc = MFMA16(af[kk], bf, acc); }
            }
            const int s = st * 16 + r;
#pragma unroll
            for (int j = 0; j < 4; ++j) { const int l = lt * 16 + q * 4 + j; As[l * KT_P + s] = (bf16)f2bf((s <= l) ? acc[j] : 0.f); }
        }
    }
    __syncthreads();
    {
        const int lt = wave & 3, eh = wave >> 2;
        const bf16* stt = (const bf16*)(p.ws + WS_UG) + (size_t)it * (128 * 64);
        bf16x8 aq[2], as_[2];
#pragma unroll
        for (int kk = 0; kk < 2; ++kk) { aq[kk] = *(const LAS bf16x8*)(qs + (lt * 16 + r) * TG_P + kk * 32 + q * 8); as_[kk] = *(const LAS bf16x8*)(As + (lt * 16 + r) * KT_P + kk * 32 + q * 8); }
#pragma unroll
        for (int et = 0; et < 4; ++et) {
            const int e = (eh * 4 + et) * 16 + r;
            f32x4 acc = {0.f, 0.f, 0.f, 0.f};
#pragma unroll
            for (int kk = 0; kk < 2; ++kk) { const bf16x8 bf = *(const LAS bf16x8*)(vT + e * KT_P + kk * 32 + q * 8); acc = MFMA16(as_[kk], bf, acc); }
#pragma unroll
            for (int kk = 0; kk < 2; ++kk) { const bf16x8 bf = *(const bf16x8*)(stt + (size_t)e * 64 + kk * 32 + q * 8); acc = MFMA16(aq[kk], bf, acc); }
#pragma unroll
            for (int j = 0; j < 4; ++j) hb[(lt * 16 + q * 4 + j) * HB_P + e] = acc[j];
        }
    }
    __syncthreads();
    {
        const int l = tid >> 3, ck = tid & 7, e0 = ck * 16;
        f32x4 x[4]; float s2 = 0.f;
#pragma unroll
        for (int i = 0; i < 4; ++i) { x[i] = *(const LAS f32x4*)(hb + l * HB_P + e0 + 4 * i); s2 += (x[i].x * x[i].x + x[i].y * x[i].y) + (x[i].z * x[i].z + x[i].w * x[i].w); }
        s2 += __shfl_xor(s2, 1); s2 += __shfl_xor(s2, 2); s2 += __shfl_xor(s2, 4);
        const float rn = 1.f / sqrtf(s2 * (1.f / 128.f) + LN_EPS);
        const bf16* gg = proj + (rowbase + l) * NPROJ + 3072 + h * 128 + e0;
        const v4u m0 = *(const v4u*)gg, m1 = *(const v4u*)(gg + 8);
        const float* gn = p.in[I_GNG] + h * 128 + e0;
        const unsigned mw[8] = {m0.x, m0.y, m0.z, m0.w, m1.x, m1.y, m1.z, m1.w};
        unsigned ow[8];
#pragma unroll
        for (int i = 0; i < 8; ++i) {
            const float xa = x[i >> 1][(i & 1) * 2], xb = x[i >> 1][(i & 1) * 2 + 1];
            ow[i] = pk2(siluf_(bflo(mw[i])) * xa * rn * gn[2 * i], siluf_(bfhi(mw[i])) * xb * rn * gn[2 * i + 1]);
        }
        bf16* y = (bf16*)(p.ws + WS_XN) + (rowbase + l) * D + 512 + h * 128 + e0;
        *(v4u*)y = (v4u){ow[0], ow[1], ow[2], ow[3]}; *(v4u*)(y + 8) = (v4u){ow[4], ow[5], ow[6], ow[7]};
    }
    __syncthreads();
}
constexpr int KS_P = 264;
constexpr int VS_P = 136;
constexpr int ATT_KS_BYTES = 128 * KS_P * 2, ATT_VS_BYTES = 256 * VS_P * 2;
static_assert(ATT_KS_BYTES + ATT_VS_BYTES <= 140 * 1024, "attention LDS");
__device__ __forceinline__ void att_stage_k(const bf16* kb, int b, int h, int hf, LAS bf16* Ks, int tid) {
#pragma unroll
    for (int i = 0; i < 8; ++i) { const int idx = tid + NTHREADS * i, m = idx >> 5, ck = idx & 31;
        const v4u v = *(const v4u*)(kb + (size_t)(b * NMEM + hf * 128 + m) * D + h * 256 + ck * 8);
        *(LAS v4u*)(Ks + m * KS_P + ck * 8) = v; }
}
__device__ __forceinline__ void att_stage_v(const bf16* vt, int b, int h, int hf, LAS bf16* Vs, int tid) {
#pragma unroll
    for (int i = 0; i < 8; ++i) { const int idx = tid + NTHREADS * i, dh = idx >> 4, ck = idx & 15;
        const v4u v = *(const v4u*)(vt + (size_t)(h * 256 + dh) * 512 + b * NMEM + hf * 128 + ck * 8);
        *(LAS v4u*)(Vs + dh * VS_P + ck * 8) = v; }
}
__device__ __forceinline__ void p7_attention(const Params& p, LAS unsigned char* lds, int unit, int wave, int lane) {
    const int rt = unit >> 2, h = unit & 3, b = rt >> 6; const int tid = wave * 64 + lane;
    const bf16* qb = (const bf16*)(p.ws + WS_QB); const bf16* kb = (const bf16*)(p.ws + WS_KB); const bf16* vt = (const bf16*)(p.ws + WS_VT);
    LAS bf16* Ks = (LAS bf16*)lds; LAS bf16* Vs = (LAS bf16*)(lds + ATT_KS_BYTES);
    const int r = lane & 15, q = lane >> 4; const size_t tok = (size_t)rt * 128 + wave * 16 + r;
    bf16x8 qf[8];
#pragma unroll
    for (int kk = 0; kk < 8; ++kk) qf[kk] = *(const bf16x8*)(qb + tok * D + h * 256 + kk * 32 + q * 8);
    f32x4 sa[16];
#pragma unroll
    for (int t = 0; t < 16; ++t) sa[t] = (f32x4){0.f, 0.f, 0.f, 0.f};
    att_stage_k(kb, b, h, 0, Ks, tid); att_stage_v(vt, b, h, 0, Vs, tid);
    __syncthreads();
#pragma unroll
    for (int mt = 0; mt < 8; ++mt)
#pragma unroll
        for (int kk = 0; kk < 8; ++kk) { const bf16x8 af = *(const LAS bf16x8*)(Ks + (mt * 16 + r) * KS_P + kk * 32 + q * 8); sa[mt] = MFMA16(af, qf[kk], sa[mt]); }
    __syncthreads();
    att_stage_k(kb, b, h, 1, Ks, tid);
    __syncthreads();
#pragma unroll
    for (int mt = 0; mt < 8; ++mt)
#pragma unroll
        for (int kk = 0; kk < 8; ++kk) { const bf16x8 af = *(const LAS bf16x8*)(Ks + (mt * 16 + r) * KS_P + kk * 32 + q * 8); sa[8 + mt] = MFMA16(af, qf[kk], sa[8 + mt]); }
    float mx = -3.0e38f;
#pragma unroll
    for (int t = 0; t < 16; ++t) mx = fmaxf(mx, fmaxf(fmaxf(sa[t][0], sa[t][1]), fmaxf(sa[t][2], sa[t][3])));
    mx = fmaxf(mx, __shfl_xor(mx, 16)); mx = fmaxf(mx, __shfl_xor(mx, 32));
    float sum = 0.f;
#pragma unroll
    for (int t = 0; t < 16; ++t)
#pragma unroll
        for (int j = 0; j < 4; ++j) { const float e = __expf(sa[t][j] - mx); sa[t][j] = e; sum += e; }
    sum += __shfl_xor(sum, 16); sum += __shfl_xor(sum, 32);
    const float inv = 1.f / sum;
    bf16x8 pf[8];
#pragma unroll
    for (int u = 0; u < 8; ++u) { v4u w; w.x = pk2(sa[2 * u][0], sa[2 * u][1]); w.y = pk2(sa[2 * u][2], sa[2 * u][3]); w.z = pk2(sa[2 * u + 1][0], sa[2 * u + 1][1]); w.w = pk2(sa[2 * u + 1][2], sa[2 * u + 1][3]);
        pf[u] = __builtin_bit_cast(bf16x8, w); }
    f32x4 oa[16];
#pragma unroll
    for (int t = 0; t < 16; ++t) oa[t] = (f32x4){0.f, 0.f, 0.f, 0.f};
#pragma unroll
    for (int hf = 0; hf < 2; ++hf) {
        if (hf == 1) { __syncthreads(); att_stage_v(vt, b, h, 1, Vs, tid); __syncthreads(); }
#pragma unroll
        for (int dt = 0; dt < 16; ++dt)
#pragma unroll
            for (int uu = 0; uu < 4; ++uu) {
                const int u = hf * 4 + uu;
                const LAS bf16* vr = Vs + (dt * 16 + r) * VS_P + (2 * uu) * 16 + q * 4;
                const v2u lo = *(const LAS v2u*)vr, hi = *(const LAS v2u*)(vr + 16);
                const v4u w = {lo.x, lo.y, hi.x, hi.y};
                oa[dt] = MFMA16(__builtin_bit_cast(bf16x8, w), pf[u], oa[dt]);
            }
    }
    bf16* ob = (bf16*)(p.ws + WS_OB) + tok * D + h * 256;
#pragma unroll
    for (int dt = 0; dt < 16; ++dt) { v2u o; o.x = pk2(oa[dt][0] * inv, oa[dt][1] * inv); o.y = pk2(oa[dt][2] * inv, oa[dt][3] * inv); *(v2u*)(ob + dt * 16 + q * 4) = o; }
    __syncthreads();
}

#ifndef USE_CG
#define USE_CG 1
#endif
__global__ void __launch_bounds__(NTHREADS, 2) hymba_fwd(Params p) {
    extern __shared__ __attribute__((aligned(16))) unsigned char lds_raw[];
    LAS unsigned char* lds = (LAS unsigned char*)lds_raw;
    cg::grid_group grid = cg::this_grid();
    const int tid = threadIdx.x, lane = tid & 63, wave = __builtin_amdgcn_readfirstlane(tid >> 6);
    const int G = gridDim.x, bx = blockIdx.x;
    const int gw = bx * NWAVES + wave, NGW = G * NWAVES;
    unsigned char* ws = p.ws;
#define GRID_BAR() grid.sync()

    p0_prologue(p, lds, gw, NGW, wave, lane);
    GRID_BAR();
    {
        pg8::Gemm g{(const pg8::bf16_t*)(ws + WS_ROWBUF), (const pg8::bf16_t*)(ws + WS_ROWBUF), M, 3840, D};
        pg8::ProjOrder S; S.init(G, bx);
        pg8::EpiProj E{(pg8::bf16_t*)(ws + WS_PROJ), (float*)(ws + WS_GATES), (pg8::bf16_t*)(ws + WS_KB), (pg8::bf16_t*)(ws + WS_VT)};
        pg8::gemm_phase<pg8::EpiProj, pg8::ProjOrder, true, true>(lds, g, S, E);
    }
    GRID_BAR();
    for (int i = bx; i < 2048; i += G) { if (i < 1024) p2_mlstm(p, lds, i, wave, lane); else p2_gla(p, lds, i - 1024, wave, lane); }
    GRID_BAR();
    p3_scan(p, gw, NGW, lane);
    GRID_BAR();
    for (int i = bx; i < 2048; i += G) { if (i < 1024) p4_mlstm(p, lds, i, wave, lane); else p4_gla(p, lds, i - 1024, wave, lane); }
    GRID_BAR();
    {
        pg8::Gemm g{(const pg8::bf16_t*)(ws + WS_XN), (const pg8::bf16_t*)(ws + WS_WOUT), M, D, D};
        pg8::StaticOrder S; S.init(M, D, G, bx);
        pg8::EpiResF32 E{p.out, p.out, D, ALPHA};
        pg8::gemm_phase<pg8::EpiResF32, pg8::StaticOrder, true, true>(lds, g, S, E);
    }
    GRID_BAR();
    ln_pass(p.out, p.out, (bf16*)(ws + WS_XN), p.in[I_LN1G], p.in[I_LN1B], gw, NGW, lane);
    GRID_BAR();
    {
        pg8::Gemm g{(const pg8::bf16_t*)(ws + WS_XN), (const pg8::bf16_t*)(ws + WS_WQ), M, D, D};
        pg8::StaticOrder S; S.init(M, D, G, bx);
        pg8::EpiAct<0> E{(pg8::bf16_t*)(ws + WS_QB), D, 0.0625f};
        pg8::gemm_phase<pg8::EpiAct<0>, pg8::StaticOrder, true, true>(lds, g, S, E);
    }
    GRID_BAR();
    for (int u = bx; u < 512; u += G) p7_attention(p, lds, u, wave, lane);
    GRID_BAR();
    {
        pg8::Gemm g{(const pg8::bf16_t*)(ws + WS_OB), (const pg8::bf16_t*)(ws + WS_WXO), M, D, D};
        pg8::StaticOrder S; S.init(M, D, G, bx);
        pg8::EpiResF32 E{p.out, p.out, D, ALPHA};
        pg8::gemm_phase<pg8::EpiResF32, pg8::StaticOrder, true, true>(lds, g, S, E);
    }
    GRID_BAR();
    ln_pass(p.out, p.out, (bf16*)(ws + WS_XN), p.in[I_LN2G], p.in[I_LN2B], gw, NGW, lane);
    GRID_BAR();
    {
        pg8::Gemm g{(const pg8::bf16_t*)(ws + WS_XN), (const pg8::bf16_t*)(ws + WS_W1), M, FF, D};
        pg8::StaticOrder S; S.init(M, FF, G, bx);
        pg8::EpiAct<2> E{(pg8::bf16_t*)(ws + WS_HB), FF, 1.f};
        pg8::gemm_phase<pg8::EpiAct<2>, pg8::StaticOrder, true, true>(lds, g, S, E);
    }
    GRID_BAR();
    {
        pg8::Gemm g{(const pg8::bf16_t*)(ws + WS_HB), (const pg8::bf16_t*)(ws + WS_W2), M, D, FF};
        pg8::StaticOrder S; S.init(M, D, G, bx);
        pg8::EpiResF32 E{p.out, p.out, D, ALPHA};
        pg8::gemm_phase<pg8::EpiResF32, pg8::StaticOrder, true, true>(lds, g, S, E);
    }
    GRID_BAR();
    ln_pass(p.out, p.out, nullptr, p.in[I_LN3G], p.in[I_LN3B], gw, NGW, lane);
}

extern "C" void kernel_launch(void* const* d_in, const int* in_sizes, int n_in, void* d_out, int out_size, void* d_ws, size_t ws_size, hipStream_t stream) {
    static int grid = 0;
    if (grid == 0) {
        if (n_in != 26 || out_size != M * D || ws_size < WS_END) { fprintf(stderr, "kernel_launch: unexpected shapes n_in %d out %d ws %zu\n", n_in, out_size, ws_size); grid = -1; return; }
        int dev = 0, cus = 0, per_cu = 0;
        (void)hipGetDevice(&dev); (void)hipDeviceGetAttribute(&cus, hipDeviceAttributeMultiprocessorCount, dev);
        (void)hipFuncSetAttribute((const void*)hymba_fwd, hipFuncAttributeMaxDynamicSharedMemorySize, LDS_BYTES);
        (void)hipOccupancyMaxActiveBlocksPerMultiprocessor(&per_cu, (const void*)hymba_fwd, NTHREADS, LDS_BYTES);
        if (per_cu < 1) { fprintf(stderr, "kernel_launch: occupancy query says %d blocks per CU\n", per_cu); per_cu = 1; }
        (void)hipGetLastError();
        grid = cus;
    }
    if (grid < 0) return;
    Params p{};
    for (int i = 0; i < 26; ++i) p.in[i] = (const float*)d_in[i];
    p.out = (float*)d_out; p.ws = (unsigned char*)d_ws;
    void* args[] = {&p};
    hipError_t e = hipLaunchCooperativeKernel((void*)hymba_fwd, dim3(grid), dim3(NTHREADS), args, LDS_BYTES, stream);
    if (e != hipSuccess) fprintf(stderr, "cooperative launch failed: %s (grid %d)\n", hipGetErrorString(e), grid);
}
```

```cpp
#include <hip/hip_runtime.h>
#include <hip/hip_cooperative_groups.h>
#include <cstdio>
#include <cstdint>
namespace cg = cooperative_groups;
namespace pg8 {
#define PG8_LAS __attribute__((address_space(3)))
typedef unsigned short bf16_t;
typedef short bf16x8 __attribute__((ext_vector_type(8)));
typedef float f32x4 __attribute__((ext_vector_type(4)));
typedef unsigned u32x4 __attribute__((ext_vector_type(4)));
constexpr int BM = 256, BK = 64, HALF = 128, HTB = HALF * BK * 2  , STAGE_BYTES = 8 * HTB, NXCD = 8, WGM = 8;

__host__ __device__ __forceinline__ int lds_byte(int r, int c) { const int st = (r >> 4) * 2 + (c >> 5), rr = r & 15, cc = c & 31, ob = rr * 64 + cc * 2; return st * 1024 + (ob ^ (((ob >> 9) & 1) << 5)); }
__host__ __device__ __forceinline__ void stage_rc(int b, int& R, int& C) { const int st = b / 1024, sb = b % 1024, swz = sb ^ (((sb >> 9) & 1) << 5); R = (st >> 1) * 16 + swz / 64; C = (st & 1) * 32 + (swz % 64) / 2; }
__host__ __device__ __forceinline__ int perm32(int rho) { const int n = rho >> 4, i = rho & 15; return 8 * (i >> 2) + 4 * n + (i & 3); }

struct Unit { int pm, pn; };
struct Gemm { const bf16_t* A; const bf16_t* Bt; int M, N, K; };

struct StaticOrder {
    int nM, nN, nwg, G, c;
    __host__ __device__ void init(int M, int N, int G_, int c_) { nM = M / BM; nN = N / BM; nwg = nM * nN; G = G_; c = c_; }
    __host__ __device__ bool next(int i, Unit& u) const {
        const long L = (long)i * G + c; if (L >= nwg) return false;
        int wgid = (int)L; { const int q = nwg / NXCD, r = nwg % NXCD, xcd = wgid % NXCD, off = wgid / NXCD; wgid = (xcd < r ? xcd * (q + 1) : r * (q + 1) + (xcd - r) * q) + off; }
        const int nig = WGM * nN, gid = wgid / nig, fm = gid * WGM, gsz = (nM - fm) < WGM ? (nM - fm) : WGM;
        u.pm = fm + ((wgid % nig) % gsz); u.pn = (wgid % nig) / gsz; return true;
    }
    __device__ __forceinline__ void a_ready(const Unit&) const {}
    __device__ __forceinline__ void done(const Unit&) const {}
};

__device__ __forceinline__ unsigned cvt_pk_bf16(float lo, float hi) { unsigned r; asm volatile("v_cvt_pk_bf16_f32 %0, %1, %2" : "=v"(r) : "v"(lo), "v"(hi)); return r; }
typedef float f32x2 __attribute__((ext_vector_type(2)));
__device__ __forceinline__ f32x2 gelu_pk(f32x2 v) {
    const f32x2 av = __builtin_elementwise_abs(v), d = av * 0.2316418882f + 1.0f;
    f32x2 t; t.x = __builtin_amdgcn_rcpf(d.x); t.y = __builtin_amdgcn_rcpf(d.y);
    f32x2 q = t * 0.5307027145f + (-0.7265760135f); q = q * t + 0.7107068705f; q = q * t + (-0.142248368f); q = q * t + 0.127414796f; q = q * t;
    const f32x2 s = (v * v) * (-0.72134752044f);
    f32x2 e; e.x = __builtin_amdgcn_exp2f(s.x); e.y = __builtin_amdgcn_exp2f(s.y);
    const f32x2 m = v * (q * e), r = v - m;
    f32x2 o; o.x = v.x < 0.f ? m.x : r.x; o.y = v.y < 0.f ? m.y : r.y; return o;
}

template <int ACT  > struct EpiBf16 {
    static constexpr bool PERM = true, AFTER_DRAIN = false; static_assert(ACT == 0 || ACT == 1, "EpiBf16: ACT is 0 (none) or 1 (gelu_pk)");
    bf16_t* O; int ldc; const float* bias; int split_cols; size_t split_stride; float scale0;
    __device__ __forceinline__ void operator()(const f32x4 (&acc)[2][2][4][2], const Unit& u, int wr, int wc, int fr, int fq) const {
        const int row0 = u.pm * BM + wr * 64 + fr; int colt = u.pn * BM; bf16_t* base = O;
        float sc = 1.f; if (split_cols) { const int t = colt / split_cols; base += (size_t)t * split_stride; colt -= t * split_cols; if (t == 0) sc = scale0; }
        const int col0 = colt + wc * 32 + 8 * fq, bcol0 = u.pn * BM + wc * 32 + 8 * fq;
        f32x4 bv[2][2];
#pragma unroll
        for (int bj = 0; bj < 2; ++bj)
#pragma unroll
            for (int n = 0; n < 2; ++n) bv[bj][n] = bias ? *(const f32x4*)(bias + bcol0 + bj * HALF + 4 * n) : (f32x4){0.f, 0.f, 0.f, 0.f};
#pragma unroll
        for (int ai = 0; ai < 2; ++ai)
#pragma unroll
            for (int m = 0; m < 4; ++m) { bf16_t* rowp = base + (size_t)(row0 + ai * HALF + m * 16) * ldc + col0;
#pragma unroll
                for (int bj = 0; bj < 2; ++bj) { f32x4 v0 = acc[ai][bj][m][0] + bv[bj][0], v1 = acc[ai][bj][m][1] + bv[bj][1];
                    if (ACT == 1) { f32x2 a = gelu_pk((f32x2){v0[0], v0[1]}), b = gelu_pk((f32x2){v0[2], v0[3]}), c = gelu_pk((f32x2){v1[0], v1[1]}), d = gelu_pk((f32x2){v1[2], v1[3]});
                        v0 = (f32x4){a.x, a.y, b.x, b.y}; v1 = (f32x4){c.x, c.y, d.x, d.y}; }
                    v0 = v0 * sc; v1 = v1 * sc; u32x4 w; w.x = cvt_pk_bf16(v0[0], v0[1]); w.y = cvt_pk_bf16(v0[2], v0[3]); w.z = cvt_pk_bf16(v1[0], v1[1]); w.w = cvt_pk_bf16(v1[2], v1[3]);
                    *(u32x4*)(rowp + bj * HALF) = w; } }
    }
};
template <class Epi, class Sched, bool ALIGN_EPI = false, bool SP2 = false>
__device__ __forceinline__ void gemm_phase(PG8_LAS unsigned char* lds, const Gemm g, const Sched& S, const Epi& E) {
    const int tid = threadIdx.x, wid = __builtin_amdgcn_readfirstlane(tid >> 6), lane = tid & 63, wr = wid >> 2, wc = wid & 3, fr = lane & 15, fq = lane >> 4;
    const int K = g.K, nt = K / BK;
    unsigned voffA[2], voffB[2];
#pragma unroll
    for (int i = 0; i < 2; ++i) { int R, C; stage_rc(tid * 16 + i * 8192, R, C); const int Rb = Epi::PERM ? ((R & ~31) + perm32(R & 31)) : R;
        voffA[i] = (unsigned)(R * K + C) * 2u; voffB[i] = (unsigned)(Rb * K + C) * 2u; }
    const size_t kstep = (size_t)(BK * 2);
    const size_t hstep = (size_t)HALF * K * 2;
    const size_t tstep = 2 * hstep;
    const unsigned ldsw = (unsigned)wid * 1024u;
    const int aoff = lds_byte(wr * 64 + fr, fq * 8), boff = lds_byte(wc * 32 + fr, fq * 8);
#define PG8_SA(b, h) (((b) * 2 + (h)) * HTB)
#define PG8_SB(b, h) ((4 + (b) * 2 + (h)) * HTB)
#define PG8_STAGE(bufoff, gbase, voff) do { _Pragma("unroll") for (int _i = 0; _i < 2; ++_i) \
        __builtin_amdgcn_global_load_lds((const unsigned*)((const char*)(gbase) + (voff)[_i]), (PG8_LAS unsigned*)(lds + (bufoff) + ldsw + _i * 8192), 16, 0, 0); } while (0)
#define PG8_LDA(dst, b, h) do { _Pragma("unroll") for (int m = 0; m < 4; ++m) _Pragma("unroll") for (int k = 0; k < 2; ++k) dst[m][k] = *(const PG8_LAS bf16x8*)(lds + PG8_SA(b, h) + aoff + m * 2048 + k * 1024); } while (0)
#define PG8_LDB(dst, b, h) do { _Pragma("unroll") for (int n = 0; n < 2; ++n) _Pragma("unroll") for (int k = 0; k < 2; ++k) dst[n][k] = *(const PG8_LAS bf16x8*)(lds + PG8_SB(b, h) + boff + n * 2048 + k * 1024); } while (0)
#define PG8_MMA(ai, bj, At, Bt) do { __builtin_amdgcn_s_setprio(1); _Pragma("unroll") for (int m = 0; m < 4; ++m) _Pragma("unroll") for (int n = 0; n < 2; ++n) _Pragma("unroll") for (int k = 0; k < 2; ++k) \
        acc[ai][bj][m][n] = __builtin_amdgcn_mfma_f32_16x16x32_bf16(Bt[n][k], At[m][k], acc[ai][bj][m][n], 0, 0, 0); __builtin_amdgcn_s_setprio(0); } while (0)
#define PG8_WAIT_V(n) asm volatile("s_waitcnt vmcnt(" #n ")" ::: "memory")
#define PG8_WAIT_L(n) asm volatile("s_waitcnt lgkmcnt(" #n ")" ::: "memory")
#define PG8_BAR __builtin_amdgcn_s_barrier()
#define PG8_SCHED __builtin_amdgcn_sched_barrier(0)
    Unit cur, nxt; int ui = 0;
    if (!S.next(0, cur)) return;
    f32x4 acc[2][2][4][2];
#pragma unroll
    for (int a = 0; a < 2; ++a)
#pragma unroll
        for (int b = 0; b < 2; ++b)
#pragma unroll
            for (int m = 0; m < 4; ++m)
#pragma unroll
                for (int n = 0; n < 2; ++n) acc[a][b][m][n] = (f32x4){0.f, 0.f, 0.f, 0.f};
    bf16x8 At[4][2], B0[2][2], B1[2][2];
    const char* cA = (const char*)g.A + (size_t)cur.pm * tstep; const char* cB = (const char*)g.Bt + (size_t)cur.pn * tstep;
    S.a_ready(cur);
    if constexpr (SP2) {
        PG8_STAGE(PG8_SB(0, 0), cB, voffB); PG8_STAGE(PG8_SB(0, 1), cB + hstep, voffB); PG8_STAGE(PG8_SA(0, 0), cA, voffA); PG8_STAGE(PG8_SA(0, 1), cA + hstep, voffA);
        if (wr == 1) PG8_BAR;
        PG8_WAIT_V(2); PG8_BAR;
        PG8_STAGE(PG8_SB(1, 0), cB + kstep, voffB); PG8_STAGE(PG8_SA(1, 0), cA + kstep, voffA); PG8_STAGE(PG8_SB(1, 1), cB + hstep + kstep, voffB);
        PG8_WAIT_V(6); PG8_BAR;
    } else {
        PG8_STAGE(PG8_SB(0, 0), cB, voffB); PG8_STAGE(PG8_SA(0, 0), cA, voffA); PG8_STAGE(PG8_SB(0, 1), cB + hstep, voffB); PG8_STAGE(PG8_SA(0, 1), cA + hstep, voffA);
        if (wr == 1) PG8_BAR;
        PG8_WAIT_V(4); PG8_BAR;
        PG8_STAGE(PG8_SB(1, 0), cB + kstep, voffB); PG8_STAGE(PG8_SA(1, 0), cA + kstep, voffA); PG8_STAGE(PG8_SB(1, 1), cB + hstep + kstep, voffB);
        PG8_WAIT_V(6); PG8_BAR;
    }
    for (;;) {
        const bool has_next = S.next(ui + 1, nxt);
        const char* nA = has_next ? (const char*)g.A + (size_t)nxt.pm * tstep : cA; const char* nB = has_next ? (const char*)g.Bt + (size_t)nxt.pn * tstep : cB;
        for (int t = 0; t < nt; t += 2) {
            const bool last = (t == nt - 2);
            const char* a1 = cA + (size_t)(t + 1) * kstep;
            const char* a2 = last ? nA : cA + (size_t)(t + 2) * kstep; const char* b2 = last ? nB : cB + (size_t)(t + 2) * kstep;
            const char* a3 = a2 + kstep; const char* b3 = b2 + kstep;
            if (last && has_next) S.a_ready(nxt);
            if constexpr (SP2) {
            PG8_LDB(B0, 0, 0); PG8_LDB(B1, 0, 1); PG8_SCHED; PG8_LDA(At, 0, 0); PG8_STAGE(PG8_SA(1, 1), a1 + hstep, voffA);
            PG8_WAIT_V(8); PG8_WAIT_L(0); PG8_BAR; PG8_MMA(0, 0, At, B0); PG8_MMA(0, 1, At, B1); PG8_BAR; PG8_SCHED;
            PG8_LDA(At, 0, 1); PG8_STAGE(PG8_SB(0, 0), b2, voffB); PG8_STAGE(PG8_SB(0, 1), b2 + hstep, voffB); PG8_STAGE(PG8_SA(0, 0), a2, voffA);
            PG8_WAIT_V(8); PG8_WAIT_L(0); PG8_BAR; PG8_MMA(1, 0, At, B0); PG8_MMA(1, 1, At, B1); PG8_BAR; PG8_SCHED;
            PG8_LDB(B0, 1, 0); PG8_LDB(B1, 1, 1); PG8_SCHED; PG8_LDA(At, 1, 0); PG8_STAGE(PG8_SA(0, 1), a2 + hstep, voffA);
            PG8_WAIT_V(8); PG8_WAIT_L(0); PG8_BAR; PG8_MMA(0, 0, At, B0); PG8_MMA(0, 1, At, B1); PG8_BAR; PG8_SCHED;
            PG8_LDA(At, 1, 1); PG8_STAGE(PG8_SB(1, 0), b3, voffB); PG8_STAGE(PG8_SB(1, 1), b3 + hstep, voffB); PG8_STAGE(PG8_SA(1, 0), a3, voffA);
            PG8_WAIT_V(8); PG8_WAIT_L(0); PG8_BAR; PG8_MMA(1, 0, At, B0); PG8_MMA(1, 1, At, B1); PG8_BAR; PG8_SCHED;
            } else {
            PG8_LDB(B0, 0, 0); PG8_SCHED; PG8_LDA(At, 0, 0); PG8_STAGE(PG8_SA(1, 1), a1 + hstep, voffA);
            PG8_WAIT_L(8); PG8_BAR; PG8_WAIT_L(0); PG8_MMA(0, 0, At, B0); PG8_BAR; PG8_SCHED;
            PG8_LDB(B1, 0, 1); PG8_STAGE(PG8_SB(0, 0), b2, voffB);
            PG8_BAR; PG8_WAIT_L(0); PG8_MMA(0, 1, At, B1); PG8_BAR;
            PG8_LDA(At, 0, 1); PG8_STAGE(PG8_SA(0, 0), a2, voffA);
            PG8_BAR; PG8_WAIT_L(0); PG8_MMA(1, 0, At, B0); PG8_BAR; PG8_SCHED;
            PG8_STAGE(PG8_SB(0, 1), b2 + hstep, voffB);
            PG8_WAIT_V(6); PG8_BAR; PG8_MMA(1, 1, At, B1); PG8_BAR;
            PG8_LDB(B0, 1, 0); PG8_SCHED; PG8_LDA(At, 1, 0); PG8_STAGE(PG8_SA(0, 1), a2 + hstep, voffA);
            PG8_WAIT_L(8); PG8_BAR; PG8_WAIT_L(0); PG8_MMA(0, 0, At, B0); PG8_BAR; PG8_SCHED;
            PG8_LDB(B1, 1, 1); PG8_STAGE(PG8_SB(1, 0), b3, voffB);
            PG8_BAR; PG8_WAIT_L(0); PG8_MMA(0, 1, At, B1); PG8_BAR;
            PG8_LDA(At, 1, 1); PG8_STAGE(PG8_SA(1, 0), a3, voffA);
            PG8_BAR; PG8_WAIT_L(0); PG8_MMA(1, 0, At, B0); PG8_BAR; PG8_SCHED;
            PG8_STAGE(PG8_SB(1, 1), b3 + hstep, voffB);
            PG8_WAIT_V(6); PG8_BAR; PG8_MMA(1, 1, At, B1); PG8_BAR;
            }
        }
        if constexpr (ALIGN_EPI) { if (wr == 0) PG8_BAR; }
        if constexpr (!Epi::AFTER_DRAIN) { E(acc, cur, wr, wc, fr, fq); S.done(cur); }
        if (!has_next) break;
#pragma unroll
        for (int a = 0; a < 2; ++a)
#pragma unroll
            for (int b = 0; b < 2; ++b)
#pragma unroll
                for (int m = 0; m < 4; ++m)
#pragma unroll
                    for (int n = 0; n < 2; ++n) acc[a][b][m][n] = (f32x4){0.f, 0.f, 0.f, 0.f};
        cur = nxt; cA = nA; cB = nB; ++ui;
        if constexpr (ALIGN_EPI) { if (wr == 1) PG8_BAR; }
    }
    PG8_WAIT_V(0);
    if constexpr (!ALIGN_EPI) { if (wr == 0) PG8_BAR; }
    PG8_BAR;
    if constexpr (Epi::AFTER_DRAIN) { E.fused(acc, cur, wr, wc, fr, fq, lds, wid, lane); S.done(cur); }
#undef PG8_SA
#undef PG8_SB
#undef PG8_STAGE
#undef PG8_LDA
#undef PG8_LDB
#undef PG8_MMA
#undef PG8_WAIT_V
#undef PG8_WAIT_L
#undef PG8_BAR
#undef PG8_SCHED
}
struct EpiResF32 {
    static constexpr bool PERM = false, AFTER_DRAIN = false;
    const float* res; float* out; int ldc; float alpha;
    __device__ __forceinline__ void operator()(const f32x4 (&acc)[2][2][4][2], const Unit& u, int wr, int wc, int fr, int fq) const {
        const int col0 = u.pn * BM + wc * 32 + 4 * fq;
#pragma unroll
        for (int ai = 0; ai < 2; ++ai)
#pragma unroll
            for (int m = 0; m < 4; ++m) { const size_t off = (size_t)(u.pm * BM + ai * HALF + wr * 64 + m * 16 + fr) * ldc + col0;
#pragma unroll
                for (int bj = 0; bj < 2; ++bj)
#pragma unroll
                    for (int n = 0; n < 2; ++n) { const f32x4 bs = *(const f32x4*)(res + off + bj * HALF + n * 16); *(f32x4*)(out + off + bj * HALF + n * 16) = bs * alpha + acc[ai][bj][m][n]; } }
    }
};
template <int ACT> struct EpiAct {
    static constexpr bool PERM = true, AFTER_DRAIN = false;
    bf16_t* O; int ldc; float scale;
    __device__ __forceinline__ void operator()(const f32x4 (&acc)[2][2][4][2], const Unit& u, int wr, int wc, int fr, int fq) const {
        const int row0 = u.pm * BM + wr * 64 + fr; const int col0 = u.pn * BM + wc * 32 + 8 * fq;
#pragma unroll
        for (int ai = 0; ai < 2; ++ai)
#pragma unroll
            for (int m = 0; m < 4; ++m) { bf16_t* rowp = O + (size_t)(row0 + ai * HALF + m * 16) * ldc + col0;
#pragma unroll
                for (int bj = 0; bj < 2; ++bj) { f32x4 v0 = acc[ai][bj][m][0], v1 = acc[ai][bj][m][1];
                    if (ACT == 2) {
#pragma unroll
                        for (int e = 0; e < 4; ++e) { float a = fmaxf(v0[e], 0.f), b = fmaxf(v1[e], 0.f); v0[e] = a * a; v1[e] = b * b; } }
                    else { v0 = v0 * scale; v1 = v1 * scale; }
                    u32x4 w; w.x = cvt_pk_bf16(v0[0], v0[1]); w.y = cvt_pk_bf16(v0[2], v0[3]); w.z = cvt_pk_bf16(v1[0], v1[1]); w.w = cvt_pk_bf16(v1[2], v1[3]);
                    *(u32x4*)(rowp + bj * HALF) = w; } }
    }
};
struct EpiProj {
    static constexpr bool PERM = true, AFTER_DRAIN = false;
    bf16_t* proj; float* gates; bf16_t* kb; bf16_t* vt;
    __device__ __forceinline__ void operator()(const f32x4 (&acc)[2][2][4][2], const Unit& u, int wr, int wc, int fr, int fq) const {
        bf16_t* base; int ldc, rowt, colt;
        if (u.pm < 64) {
            if (u.pn == 84) {
                if (wc == 0) {
#pragma unroll
                    for (int ai = 0; ai < 2; ++ai)
#pragma unroll
                        for (int m = 0; m < 4; ++m) { float* g = gates + (size_t)(u.pm * BM + ai * HALF + wr * 64 + m * 16 + fr) * 32 + 8 * fq;
                            *(f32x4*)g = acc[ai][0][m][0]; *(f32x4*)(g + 4) = acc[ai][0][m][1]; }
                }
                return;
            }
            base = proj; ldc = 3584; rowt = u.pm * BM; colt = (u.pn - 70) * BM;
        } else if (u.pm < 66) { base = kb; ldc = 1024; rowt = (u.pm - 64) * BM; colt = (u.pn - 85) * BM; }
        else { base = vt; ldc = 512; rowt = (u.pm - 66) * BM; colt = (u.pn - 64) * BM; }
        const int row0 = rowt + wr * 64 + fr; const int col0 = colt + wc * 32 + 8 * fq;
#pragma unroll
        for (int ai = 0; ai < 2; ++ai)
#pragma unroll
            for (int m = 0; m < 4; ++m) { bf16_t* rowp = base + (size_t)(row0 + ai * HALF + m * 16) * ldc + col0;
#pragma unroll
                for (int bj = 0; bj < 2; ++bj) { const f32x4 v0 = acc[ai][bj][m][0], v1 = acc[ai][bj][m][1];
                    u32x4 w; w.x = cvt_pk_bf16(v0[0], v0[1]); w.y = cvt_pk_bf16(v0[2], v0[3]); w.z = cvt_pk_bf16(v1[0], v1[1]); w.w = cvt_pk_bf16(v1[2], v1[3]);
                    *(u32x4*)(rowp + bj * HALF) = w; } }
    }
};
struct ProjOrder {
    StaticOrder so; int G, c;
    __host__ __device__ void init(int G_, int c_) { so.init(16384, 3840, G_, c_); G = G_; c = c_; }
    __host__ __device__ bool next(int i, Unit& u) const {
        const long L = (long)i * G + c;
        if (L < 960) { so.next(i, u); u.pn += 70; return true; }
        const int x = (int)(L - 960);
        if (x < 8) { u.pm = 64 + (x >> 2); u.pn = 85 + (x & 3); return true; }
        if (x < 16) { const int y = x - 8; u.pm = 66 + (y >> 1); u.pn = 64 + (y & 1); return true; }
        return false;
    }
    __device__ __forceinline__ void a_ready(const Unit&) const {}
    __device__ __forceinline__ void done(const Unit&) const {}
};
}

constexpr int NWAVES = 8, NTHREADS = 512;
constexpr int BATCH = 2, T = 8192, D = 1024, M = BATCH * T, FF = 4096, NMEM = 256;
constexpr int CH = 64, NC = T / CH;
constexpr int NPROJ = 3584;
constexpr int IN_COLS = 3608;
constexpr float LN_EPS = 1e-5f;
constexpr float ALPHA = 1.189207115002721f;
constexpr size_t MiB = 1u << 20;
constexpr size_t WS_CTL = 0;
constexpr size_t WS_ROWBUF = 2 * MiB;
constexpr size_t TILE_B = 256 * 1024 * 2;
constexpr size_t WS_XN = WS_ROWBUF, WS_MEMB = WS_ROWBUF + 64 * TILE_B, WS_WVT = WS_ROWBUF + 66 * TILE_B, WS_WINT = WS_ROWBUF + 70 * TILE_B, WS_WKT = WS_ROWBUF + 85 * TILE_B;
constexpr size_t WS_WOUT = 47 * MiB, WS_WQ = 49 * MiB, WS_WXO = 51 * MiB, WS_W1 = 53 * MiB, WS_W2 = 61 * MiB;
constexpr size_t WS_KB = 69 * MiB, WS_VT = 70 * MiB, WS_GATES = 71 * MiB, WS_STATS = 73 * MiB;
constexpr size_t WS_PROJ = 74 * MiB;
constexpr size_t WS_UM = 186 * MiB;
constexpr size_t WS_UG = 222 * MiB;
constexpr size_t WS_QB = 74 * MiB, WS_OB = 106 * MiB, WS_HB = 74 * MiB;
constexpr size_t WS_END = 238 * MiB;
static_assert(WS_ROWBUF + 89 * TILE_B <= WS_WOUT, "ws map");
constexpr int ST_SM = 0, ST_MPREV = 2048, ST_GDEC = 4096;

constexpr int LDS_BYTES = 147456;
constexpr int MISC_OFF = 144 * 1024 - 256;

#define LAS __attribute__((address_space(3)))
typedef unsigned short bf16;
typedef unsigned v4u __attribute__((ext_vector_type(4)));
typedef unsigned v2u __attribute__((ext_vector_type(2)));
typedef float f32x4 __attribute__((ext_vector_type(4)));
typedef short bf16x8 __attribute__((ext_vector_type(8)));

__device__ __forceinline__ unsigned f2bf(float f) { unsigned u = __builtin_bit_cast(unsigned, f); return (u + 0x7fffu + ((u >> 16) & 1u)) >> 16; }
__device__ __forceinline__ unsigned pk2(float lo, float hi) { return f2bf(lo) | (f2bf(hi) << 16); }
__device__ __forceinline__ float bflo(unsigned w) { return __builtin_bit_cast(float, w << 16); }
__device__ __forceinline__ float bfhi(unsigned w) { return __builtin_bit_cast(float, w & 0xffff0000u); }
__device__ __forceinline__ float bf1(bf16 h) { return __builtin_bit_cast(float, (unsigned)h << 16); }
__device__ __forceinline__ float sigmoidf_(float x) { return 1.f / (1.f + __expf(-x)); }
__device__ __forceinline__ float siluf_(float x) { return x / (1.f + __expf(-x)); }
__device__ __forceinline__ float logsigmoidf_(float x) { return fminf(x, 0.f) - log1pf(__expf(-fabsf(x))); }
__device__ __forceinline__ float wave_sum(float v) {
#pragma unroll
    for (int o = 1; o < 64; o <<= 1) v += __shfl_xor(v, o);
    return v;
}
__device__ __forceinline__ float wave_max(float v) {
#pragma unroll
    for (int o = 1; o < 64; o <<= 1) v = fmaxf(v, __shfl_xor(v, o));
    return v;
}
__device__ __forceinline__ float wave_incl_sum(float v, int lane) {
#pragma unroll
    for (int o = 1; o < 64; o <<= 1) { const float t = __shfl_up(v, o); if (lane >= o) v += t; }
    return v;
}
__device__ __forceinline__ float wave_incl_max(float v, int lane) {
#pragma unroll
    for (int o = 1; o < 64; o <<= 1) { const float t = __shfl_up(v, o); if (lane >= o) v = fmaxf(v, t); }
    return v;
}
#define MFMA16(a, b, c) __builtin_amdgcn_mfma_f32_16x16x32_bf16((a), (b), (c), 0, 0, 0)

struct Params {
    const float* in[26];
    float* out; unsigned char* ws;
};
enum { I_X = 0, I_MEM, I_LNIN_G, I_LNIN_B, I_WIN, I_CONVW, I_CONVB, I_MIB, I_MFB, I_MNG, I_GLRW, I_GLRB, I_GNG, I_WOUT, I_LN1G, I_LN1B, I_XWQ, I_XWK, I_XWV, I_XWO, I_LN2G, I_LN2B, I_WFF1, I_WFF2, I_LN3G, I_LN3B };

__device__ __forceinline__ void p0_transpose_item(const float* W, int ldw, int col0, int nblk, int K, bf16* WT, int row_off, LAS float* scr, int item, int lane) {
    const int kb = item / nblk, nb = item % nblk, k0 = 64 * kb, n0 = 32 * nb;
#pragma unroll 8
    for (int i = 0; i < 32; ++i) { const int kk = 2 * i + (lane >> 5); scr[kk * 33 + (lane & 31)] = W[(size_t)(k0 + kk) * ldw + col0 + n0 + (lane & 31)]; }
    asm volatile("s_waitcnt lgkmcnt(0)" ::: "memory");
    const int c = lane & 7;
#pragma unroll
    for (int j = 0; j < 4; ++j) { const int n = (lane >> 3) + 8 * j; const LAS float* s = scr + (8 * c) * 33 + n;
        v4u o; o.x = pk2(s[0 * 33], s[1 * 33]); o.y = pk2(s[2 * 33], s[3 * 33]); o.z = pk2(s[4 * 33], s[5 * 33]); o.w = pk2(s[6 * 33], s[7 * 33]);
        *(v4u*)(WT + (size_t)(row_off + n0 + n) * K + k0 + 8 * c) = o; }
    asm volatile("s_waitcnt lgkmcnt(0)" ::: "memory");
}
__device__ __forceinline__ void ln_row(const float* xrow, float* of, bf16* ob, const float* g, const float* b, int lane) {
    const f32x4* xr = (const f32x4*)xrow + lane;
    f32x4 v[4]; float s = 0.f;
#pragma unroll
    for (int j = 0; j < 4; ++j) { v[j] = xr[64 * j]; s += (v[j].x + v[j].y) + (v[j].z + v[j].w); }
    const float mean = wave_sum(s) * (1.f / D); float s2 = 0.f;
#pragma unroll
    for (int j = 0; j < 4; ++j) { v[j] = v[j] - mean; s2 += (v[j].x * v[j].x + v[j].y * v[j].y) + (v[j].z * v[j].z + v[j].w * v[j].w); }
    const float rstd = 1.f / sqrtf(wave_sum(s2) * (1.f / D) + LN_EPS);
#pragma unroll
    for (int j = 0; j < 4; ++j) {
        const f32x4 gv = ((const f32x4*)g)[lane + 64 * j], bv = ((const f32x4*)b)[lane + 64 * j];
        const f32x4 o = v[j] * rstd * gv + bv;
        if (of) ((f32x4*)of)[lane + 64 * j] = o;
        if (ob) ((unsigned long long*)ob)[lane + 64 * j] = (unsigned long long)pk2(o.x, o.y) | ((unsigned long long)pk2(o.z, o.w) << 32);
    }
}
__device__ __forceinline__ void ln_pass(const float* src, float* of, bf16* ob, const float* g, const float* b, int gw, int NGW, int lane) {
    for (int m = gw; m < M; m += NGW) ln_row(src + (size_t)m * D, of ? of + (size_t)m * D : nullptr, ob ? ob + (size_t)m * D : nullptr, g, b, lane);
}

__device__ __forceinline__ void p0_prologue(const Params& p, LAS unsigned char* lds, int gw, int NGW, int wave, int lane) {
    unsigned char* ws = p.ws;
    LAS float* scr = (LAS float*)(lds + wave * 16384);
    constexpr int I_IN1 = (D / 64) * (2048 / 32), I_IN2 = (D / 64) * (1536 / 32), I_DD = (D / 64) * (D / 32), I_F1 = (D / 64) * (FF / 32), I_F2 = (FF / 64) * (D / 32);
    constexpr int NITEMS = I_IN1 + I_IN2 + 5 * I_DD + I_F1 + I_F2;
    for (int it = gw; it < NITEMS; it += NGW) {
        int r = it;
        if (r < I_IN1) { p0_transpose_item(p.in[I_WIN], IN_COLS, 0, 2048 / 32, D, (bf16*)(ws + WS_WINT), 0, scr, r, lane); continue; } r -= I_IN1;
        if (r < I_IN2) { p0_transpose_item(p.in[I_WIN], IN_COLS, 2056, 1536 / 32, D, (bf16*)(ws + WS_WINT), 2048, scr, r, lane); continue; } r -= I_IN2;
        if (r < I_DD) { p0_transpose_item(p.in[I_WOUT], D, 0, D / 32, D, (bf16*)(ws + WS_WOUT), 0, scr, r, lane); continue; } r -= I_DD;
        if (r < I_DD) { p0_transpose_item(p.in[I_XWQ], D, 0, D / 32, D, (bf16*)(ws + WS_WQ), 0, scr, r, lane); continue; } r -= I_DD;
        if (r < I_DD) { p0_transpose_item(p.in[I_XWK], D, 0, D / 32, D, (bf16*)(ws + WS_WKT), 0, scr, r, lane); continue; } r -= I_DD;
        if (r < I_DD) { p0_transpose_item(p.in[I_XWV], D, 0, D / 32, D, (bf16*)(ws + WS_WVT), 0, scr, r, lane); continue; } r -= I_DD;
        if (r < I_DD) { p0_transpose_item(p.in[I_XWO], D, 0, D / 32, D, (bf16*)(ws + WS_WXO), 0, scr, r, lane); continue; } r -= I_DD;
        if (r < I_F1) { p0_transpose_item(p.in[I_WFF1], FF, 0, FF / 32, D, (bf16*)(ws + WS_W1), 0, scr, r, lane); continue; } r -= I_F1;
        p0_transpose_item(p.in[I_WFF2], D, 0, D / 32, FF, (bf16*)(ws + WS_W2), 0, scr, r, lane);
    }
    {
        bf16* wt = (bf16*)(ws + WS_WINT);
        const int gt = gw * 64 + lane, NGT = NGW * 64;
        for (int e = gt; e < 24 * D; e += NGT) { const int j = e / D, k = e % D; const int sc = j < 8 ? 2048 + j : 3592 + (j - 8);
            wt[(size_t)(3584 + j) * D + k] = (bf16)f2bf(p.in[I_WIN][(size_t)k * IN_COLS + sc]); }
        v4u z = {0u, 0u, 0u, 0u};
        for (int e = gt; e < 232 * D / 8; e += NGT) ((v4u*)(wt + (size_t)3608 * D))[e] = z;
        const float* mem = p.in[I_MEM]; bf16* mb = (bf16*)(ws + WS_MEMB);
        for (int e = gt; e < 512 * D / 4; e += NGT) { const f32x4 v = ((const f32x4*)mem)[e]; ((unsigned long long*)mb)[e] = (unsigned long long)pk2(v.x, v.y) | ((unsigned long long)pk2(v.z, v.w) << 32); }
    }
    ln_pass(p.in[I_X], p.out, (bf16*)(ws + WS_XN), p.in[I_LNIN_G], p.in[I_LNIN_B], gw, NGW, lane);
}
constexpr int KT_P = 72;
constexpr int TK_P = 136;
constexpr int TG_P = 72;
constexpr int HB_P = 132;

__device__ __forceinline__ void conv_silu_pair(const bf16* proj, const float* cw, const float* cb, int b, int c, int l0, int pcol, int ch, float (&o0)[8], float (&o1)[8]) {
    float x0[11], x1[11];
    const int t0 = c * CH + l0 - 3;
#pragma unroll
    for (int i = 0; i < 11; ++i) {
        const int t = t0 + i; unsigned w = 0u;
        if (t >= 0) w = *(const unsigned*)(proj + (size_t)(b * T + t) * NPROJ + pcol);
        x0[i] = bflo(w); x1[i] = bfhi(w);
    }
    float w0[4], w1[4];
#pragma unroll
    for (int j = 0; j < 4; ++j) { w0[j] = cw[j * 1024 + ch]; w1[j] = cw[j * 1024 + ch + 1]; }
    const float b0 = cb[ch], b1 = cb[ch + 1];
#pragma unroll
    for (int j = 0; j < 8; ++j) {
        float a0 = b0, a1 = b1;
#pragma unroll
        for (int k = 0; k < 4; ++k) { a0 += w0[k] * x0[j + k]; a1 += w1[k] * x1[j + k]; }
        o0[j] = siluf_(a0); o1[j] = siluf_(a1);
    }
}
__device__ __forceinline__ void stage_vT(const bf16* proj, size_t rowbase, int l0, int pcol, LAS bf16* img, int lane) {
    unsigned w[8];
#pragma unroll
    for (int j = 0; j < 8; ++j) w[j] = *(const unsigned*)(proj + (rowbase + l0 + j) * NPROJ + pcol + 2 * lane);
    v4u a, bq;
    a.x = (w[0] & 0xffffu) | (w[1] << 16); a.y = (w[2] & 0xffffu) | (w[3] << 16); a.z = (w[4] & 0xffffu) | (w[5] << 16); a.w = (w[6] & 0xffffu) | (w[7] << 16);
    bq.x = (w[0] >> 16) | (w[1] & 0xffff0000u); bq.y = (w[2] >> 16) | (w[3] & 0xffff0000u); bq.z = (w[4] >> 16) | (w[5] & 0xffff0000u); bq.w = (w[6] >> 16) | (w[7] & 0xffff0000u);
    *(LAS v4u*)(img + (2 * lane) * KT_P + l0) = a;
    *(LAS v4u*)(img + (2 * lane + 1) * KT_P + l0) = bq;
}
__device__ __forceinline__ v4u pack8(const float (&x)[8]) { v4u r; r.x = pk2(x[0], x[1]); r.y = pk2(x[2], x[3]); r.z = pk2(x[4], x[5]); r.w = pk2(x[6], x[7]); return r; }

__device__ __forceinline__ void mlstm_gates(const Params& p, size_t rowbase, int h, int lane, float& bcum, float& logi) {
    const float* gates = (const float*)(p.ws + WS_GATES);
    const float ipre = gates[(rowbase + lane) * 32 + h] + p.in[I_MIB][h];
    const float fpre = gates[(rowbase + lane) * 32 + 4 + h] + p.in[I_MFB][h];
    bcum = wave_incl_sum(logsigmoidf_(fpre), lane); logi = ipre;
}

__device__ __forceinline__ void p2_mlstm(const Params& p, LAS unsigned char* lds, int it, int wave, int lane) {
    const int c = it % NC, bh = it / NC, h = bh & 3, b = bh >> 2; const size_t rowbase = (size_t)b * T + (size_t)c * CH;
    const bf16* proj = (const bf16*)(p.ws + WS_PROJ);
    LAS bf16* kT = (LAS bf16*)lds;
    LAS bf16* vT = (LAS bf16*)(lds + 128 * KT_P * 2);
    float bcum, logi; mlstm_gates(p, rowbase, h, lane, bcum, logi);
    const float g = __shfl(bcum, 63);
    const float a = g - bcum + logi; const float amax = wave_max(a); const float wl = __expf(a - amax);
    if (wave == 0 && lane == 0) { float* sm = (float*)(p.ws + WS_STATS) + ST_SM + 2 * it; sm[0] = g; sm[1] = amax; }
    const int l0 = wave * 8;
    float k0[8], k1[8];
    conv_silu_pair(proj, p.in[I_CONVW], p.in[I_CONVB], b, c, l0, 512 + h * 128 + 2 * lane, 512 + h * 128 + 2 * lane, k0, k1);
#pragma unroll
    for (int j = 0; j < 8; ++j) { const float s = __shfl(wl, l0 + j) * 0.08838834764831845f; k0[j] *= s; k1[j] *= s; }
    *(LAS v4u*)(kT + (2 * lane) * KT_P + l0) = pack8(k0);
    *(LAS v4u*)(kT + (2 * lane + 1) * KT_P + l0) = pack8(k1);
    stage_vT(proj, rowbase, l0, 1024 + h * 128, vT, lane);
    for (int idx = wave * 64 + lane; idx < 16 * 64; idx += NTHREADS) { const int e = 128 + (idx >> 6), l = idx & 63; vT[e * KT_P + l] = (e == 128) ? (bf16)0x3F80 : (bf16)0; }
    __syncthreads();
    const int r = lane & 15, q = lane >> 4, d0 = wave * 16;
    bf16x8 af[2];
#pragma unroll
    for (int kk = 0; kk < 2; ++kk) af[kk] = *(const LAS bf16x8*)(kT + (d0 + r) * KT_P + kk * 32 + q * 8);
    bf16* um = (bf16*)(p.ws + WS_UM) + (size_t)it * (144 * 128);
#pragma unroll
    for (int et = 0; et < 9; ++et) {
        f32x4 acc = {0.f, 0.f, 0.f, 0.f};
#pragma unroll
        for (int kk = 0; kk < 2; ++kk) { const bf16x8 bf = *(const LAS bf16x8*)(vT + (et * 16 + r) * KT_P + kk * 32 + q * 8); acc = MFMA16(af[kk], bf, acc); }
        v2u o; o.x = pk2(acc[0], acc[1]); o.y = pk2(acc[2], acc[3]);
        *(v2u*)(um + (size_t)(et * 16 + r) * 128 + d0 + q * 4) = o;
    }
    __syncthreads();
}

__device__ __forceinline__ void gla_decay(const Params& p, size_t rowbase, int h, int wave, int lane, LAS float* tot, float (&bc)[8], float& gtot) {
    const float* gates = (const float*)(p.ws + WS_GATES);
    float wr[16];
#pragma unroll
    for (int r = 0; r < 16; ++r) wr[r] = p.in[I_GLRW][r * 256 + h * 64 + lane];
    const float bias = p.in[I_GLRB][h * 64 + lane];
    float run = 0.f;
#pragma unroll
    for (int j = 0; j < 8; ++j) {
        const float* gl = gates + (rowbase + wave * 8 + j) * 32 + 8;
        float z = bias;
#pragma unroll
        for (int r = 0; r < 16; ++r) z += gl[r] * wr[r];
        run += logsigmoidf_(z) * (1.f / 16.f); bc[j] = run;
    }
    tot[wave * 64 + lane] = run;
    __syncthreads();
    float pre = 0.f, all = 0.f;
#pragma unroll
    for (int w = 0; w < 8; ++w) { const float t = tot[w * 64 + lane]; all += t; if (w < wave) pre += t; }
#pragma unroll
    for (int j = 0; j < 8; ++j) bc[j] += pre;
    gtot = all;
}

__device__ __forceinline__ void p2_gla(const Params& p, LAS unsigned char* lds, int it, int wave, int lane) {
    const int c = it % NC, bh = it / NC, h = bh & 3, b = bh >> 2; const size_t rowbase = (size_t)b * T + (size_t)c * CH;
    const bf16* proj = (const bf16*)(p.ws + WS_PROJ);
    LAS bf16* kT = (LAS bf16*)lds;
    LAS bf16* vT = (LAS bf16*)(lds + 64 * KT_P * 2);
    LAS float* tot = (LAS float*)(lds + 64 * KT_P * 2 + 128 * KT_P * 2);
    LAS float* gl = tot + 512;
    float bc[8], gtot; gla_decay(p, rowbase, h, wave, lane, tot, bc, gtot);
    const int l0 = wave * 8;
    float kk_[8];
#pragma unroll
    for (int j = 0; j < 8; ++j) kk_[j] = bf1(proj[(rowbase + l0 + j) * NPROJ + 2304 + h * 64 + lane]) * __expf(-bc[j]);
    *(LAS v4u*)(kT + lane * KT_P + l0) = pack8(kk_);
    stage_vT(proj, rowbase, l0, 2560 + h * 128, vT, lane);
    if (wave == 0) { gl[lane] = gtot; ((float*)(p.ws + WS_STATS))[ST_GDEC + it * 64 + lane] = gtot; }
    __syncthreads();
    const int r = lane & 15, q = lane >> 4, d0 = (wave & 3) * 16, e0 = (wave >> 2) * 64;
    bf16x8 af[2];
#pragma unroll
    for (int kk = 0; kk < 2; ++kk) af[kk] = *(const LAS bf16x8*)(kT + (d0 + r) * KT_P + kk * 32 + q * 8);
    float eg[4];
#pragma unroll
    for (int j = 0; j < 4; ++j) eg[j] = __expf(gl[d0 + q * 4 + j]);
    bf16* ug = (bf16*)(p.ws + WS_UG) + (size_t)it * (128 * 64);
#pragma unroll
    for (int et = 0; et < 4; ++et) {
        f32x4 acc = {0.f, 0.f, 0.f, 0.f};
#pragma unroll
        for (int kk = 0; kk < 2; ++kk) { const bf16x8 bf = *(const LAS bf16x8*)(vT + (e0 + et * 16 + r) * KT_P + kk * 32 + q * 8); acc = MFMA16(af[kk], bf, acc); }
        v2u o; o.x = pk2(acc[0] * eg[0], acc[1] * eg[1]); o.y = pk2(acc[2] * eg[2], acc[3] * eg[3]);
        *(v2u*)(ug + (size_t)(e0 + et * 16 + r) * 64 + d0 + q * 4) = o;
    }
    __syncthreads();
}

__device__ __forceinline__ void p3_scan(const Params& p, int gw, int NGW, int lane) {
    float* st = (float*)(p.ws + WS_STATS);
    for (int wi = gw; wi < 8 * 129 + 8 * 64; wi += NGW) {
        if (wi < 8 * 129) {
            const int bh = wi / 129, row = wi % 129;
            unsigned* base = (unsigned*)((bf16*)(p.ws + WS_UM) + ((size_t)bh * NC * 144 + row) * 128) + lane;
            const size_t cstep = 144 * 128 / 2;
            float c0 = 0.f, c1 = 0.f, m = 0.f;
            for (int cb = 0; cb < NC; cb += 8) {
                unsigned u[8];
#pragma unroll
                for (int j = 0; j < 8; ++j) u[j] = base[(size_t)(cb + j) * cstep];
#pragma unroll
                for (int j = 0; j < 8; ++j) {
                    const int c = cb + j;
                    const float g = st[ST_SM + 2 * (bh * NC + c)], am = st[ST_SM + 2 * (bh * NC + c) + 1];
                    base[(size_t)c * cstep] = pk2(c0, c1);
                    if (row == 0 && lane == 0) st[ST_MPREV + bh * NC + c] = m;
                    const float mn = fmaxf(g + m, am), dec = __expf(g + m - mn), inj = __expf(am - mn);
                    c0 = dec * c0 + inj * bflo(u[j]); c1 = dec * c1 + inj * bfhi(u[j]); m = mn;
                }
            }
        } else {
            const int w2 = wi - 8 * 129, bh = w2 >> 6, rp = w2 & 63;
            unsigned* base = (unsigned*)((bf16*)(p.ws + WS_UG) + ((size_t)bh * NC * 128 + 2 * rp) * 64) + lane;
            const size_t cstep = 128 * 64 / 2;
            const int d = (2 * lane) & 63;
            float c0 = 0.f, c1 = 0.f;
            for (int cb = 0; cb < NC; cb += 8) {
                unsigned u[8];
#pragma unroll
                for (int j = 0; j < 8; ++j) u[j] = base[(size_t)(cb + j) * cstep];
#pragma unroll
                for (int j = 0; j < 8; ++j) {
                    const int c = cb + j;
                    const float g0 = st[ST_GDEC + (bh * NC + c) * 64 + d], g1 = st[ST_GDEC + (bh * NC + c) * 64 + d + 1];
                    base[(size_t)c * cstep] = pk2(c0, c1);
                    c0 = __expf(g0) * c0 + bflo(u[j]); c1 = __expf(g1) * c1 + bfhi(u[j]);
                }
            }
        }
    }
}
__device__ __forceinline__ void p4_mlstm(const Params& p, LAS unsigned char* lds, int it, int wave, int lane) {
    const int c = it % NC, bh = it / NC, h = bh & 3, b = bh >> 2; const size_t rowbase = (size_t)b * T + (size_t)c * CH;
    const bf16* proj = (const bf16*)(p.ws + WS_PROJ);
    LAS bf16* qs = (LAS bf16*)lds;
    LAS bf16* ks = (LAS bf16*)(lds + 17408);
    LAS bf16* vT = (LAS bf16*)(lds + 34816);
    LAS bf16* Ss = (LAS bf16*)(lds + 53248);
    LAS float* hb = (LAS float*)(lds + 62464);
    LAS float* fl = (LAS float*)(lds + 96256);
    LAS float* li_s = fl, *mm_s = fl + 64, *sc_s = fl + 128, *emt_s = fl + 192, *denp = fl + 256, *deni = fl + 512;
    const int tid = wave * 64 + lane;
    {
        float bcum, logi; mlstm_gates(p, rowbase, h, lane, bcum, logi);
        const float li = logi - bcum; const float mrun = wave_incl_max(li, lane);
        const float mprev = ((const float*)(p.ws + WS_STATS))[ST_MPREV + it];
        const float mm = fmaxf(mprev, mrun);
        if (wave == 0) { li_s[lane] = li; mm_s[lane] = mm; sc_s[lane] = __expf(mprev - mm); emt_s[lane] = __expf(-(bcum + mm)); }
    }
    const int l0 = wave * 8;
    {
        float a0[8], a1[8];
        conv_silu_pair(proj, p.in[I_CONVW], p.in[I_CONVB], b, c, l0, h * 128 + 2 * lane, h * 128 + 2 * lane, a0, a1);
#pragma unroll
        for (int j = 0; j < 8; ++j) *(LAS unsigned*)(qs + (l0 + j) * TK_P + 2 * lane) = pk2(a0[j], a1[j]);
        conv_silu_pair(proj, p.in[I_CONVW], p.in[I_CONVB], b, c, l0, 512 + h * 128 + 2 * lane, 512 + h * 128 + 2 * lane, a0, a1);
#pragma unroll
        for (int j = 0; j < 8; ++j) *(LAS unsigned*)(ks + (l0 + j) * TK_P + 2 * lane) = pk2(a0[j] * 0.08838834764831845f, a1[j] * 0.08838834764831845f);
    }
    stage_vT(proj, rowbase, l0, 1024 + h * 128, vT, lane);
    __syncthreads();
    const int r = lane & 15, q = lane >> 4;
    {
        const int lt = wave >> 1;
        bf16x8 af[4];
#pragma unroll
        for (int kk = 0; kk < 4; ++kk) af[kk] = *(const LAS bf16x8*)(qs + (lt * 16 + r) * TK_P + kk * 32 + q * 8);
#pragma unroll
        for (int si = 0; si < 2; ++si) {
            const int st = 2 * (wave & 1) + si;
            f32x4 acc = {0.f, 0.f, 0.f, 0.f};
            if (st <= lt) {
#pragma unroll
                for (int kk = 0; kk < 4; ++kk) { const bf16x8 bf = *(const LAS bf16x8*)(ks + (st * 16 + r) * TK_P + kk * 32 + q * 8); acc = MFMA16(af[kk], bf, acc); }
            }
            const int s = st * 16 + r; const float lis = li_s[s];
#pragma unroll
            for (int j = 0; j < 4; ++j) {
                const int l = lt * 16 + q * 4 + j;
                float v = (s <= l) ? acc[j] * __expf(lis - mm_s[l]) : 0.f;
                Ss[l * KT_P + s] = (bf16)f2bf(v);
                v += __shfl_xor(v, 1); v += __shfl_xor(v, 2); v += __shfl_xor(v, 4); v += __shfl_xor(v, 8);
                if (r == 0) denp[st * 64 + l] = v;
            }
        }
    }
    __syncthreads();
    const int lt = wave & 3, eh = wave >> 2;
    f32x4 acc1[4], acc2[4], accd = {0.f, 0.f, 0.f, 0.f};
    {
        const bf16* ct = (const bf16*)(p.ws + WS_UM) + (size_t)it * (144 * 128);
        bf16x8 aq[4], as_[2];
#pragma unroll
        for (int kk = 0; kk < 4; ++kk) aq[kk] = *(const LAS bf16x8*)(qs + (lt * 16 + r) * TK_P + kk * 32 + q * 8);
#pragma unroll
        for (int kk = 0; kk < 2; ++kk) as_[kk] = *(const LAS bf16x8*)(Ss + (lt * 16 + r) * KT_P + kk * 32 + q * 8);
#pragma unroll
        for (int et = 0; et < 4; ++et) {
            const int e = (eh * 4 + et) * 16 + r;
            acc1[et] = (f32x4){0.f, 0.f, 0.f, 0.f}; acc2[et] = (f32x4){0.f, 0.f, 0.f, 0.f};
#pragma unroll
            for (int kk = 0; kk < 2; ++kk) { const bf16x8 bf = *(const LAS bf16x8*)(vT + e * KT_P + kk * 32 + q * 8); acc1[et] = MFMA16(as_[kk], bf, acc1[et]); }
#pragma unroll
            for (int kk = 0; kk < 4; ++kk) { const bf16x8 bf = *(const bf16x8*)(ct + (size_t)e * 128 + kk * 32 + q * 8); acc2[et] = MFMA16(aq[kk], bf, acc2[et]); }
        }
        if (eh == 0) {
#pragma unroll
            for (int kk = 0; kk < 4; ++kk) { const bf16x8 bf = *(const bf16x8*)(ct + (size_t)(128 + r) * 128 + kk * 32 + q * 8); accd = MFMA16(aq[kk], bf, accd); }
            if (r == 0) {
#pragma unroll
                for (int j = 0; j < 4; ++j) { const int l = lt * 16 + q * 4 + j; deni[l] = sc_s[l] * accd[j]; }
            }
        }
    }
    __syncthreads();
#pragma unroll
    for (int j = 0; j < 4; ++j) {
        const int l = lt * 16 + q * 4 + j;
        const float den = ((denp[l] + denp[64 + l]) + (denp[128 + l] + denp[192 + l])) + deni[l];
        const float inv = 1.f / fmaxf(fabsf(den), emt_s[l]); const float sc = sc_s[l];
#pragma unroll
        for (int et = 0; et < 4; ++et) hb[l * HB_P + (eh * 4 + et) * 16 + r] = (acc1[et][j] + sc * acc2[et][j]) * inv;
    }
    __syncthreads();
    {
        const int l = tid >> 3, ck = tid & 7, e0 = ck * 16;
        f32x4 x[4]; float s = 0.f;
#pragma unroll
        for (int i = 0; i < 4; ++i) { x[i] = *(const LAS f32x4*)(hb + l * HB_P + e0 + 4 * i); s += (x[i].x + x[i].y) + (x[i].z + x[i].w); }
        s += __shfl_xor(s, 1); s += __shfl_xor(s, 2); s += __shfl_xor(s, 4);
        const float mean = s * (1.f / 128.f); float s2 = 0.f;
#pragma unroll
        for (int i = 0; i < 4; ++i) { x[i] = x[i] - mean; s2 += (x[i].x * x[i].x + x[i].y * x[i].y) + (x[i].z * x[i].z + x[i].w * x[i].w); }
        s2 += __shfl_xor(s2, 1); s2 += __shfl_xor(s2, 2); s2 += __shfl_xor(s2, 4);
        const float rstd = 1.f / sqrtf(s2 * (1.f / 128.f) + LN_EPS);
        const bf16* mo = proj + (rowbase + l) * NPROJ + 1536 + h * 128 + e0;
        const v4u m0 = *(const v4u*)mo, m1 = *(const v4u*)(mo + 8);
        const float* gn = p.in[I_MNG] + h * 128 + e0;
        const unsigned mw[8] = {m0.x, m0.y, m0.z, m0.w, m1.x, m1.y, m1.z, m1.w};
        unsigned ow[8];
#pragma unroll
        for (int i = 0; i < 8; ++i) {
            const float xa = x[i >> 1][(i & 1) * 2], xb = x[i >> 1][(i & 1) * 2 + 1];
            const float ya = sigmoidf_(bflo(mw[i])) * xa * rstd * gn[2 * i], yb = sigmoidf_(bfhi(mw[i])) * xb * rstd * gn[2 * i + 1];
            ow[i] = pk2(ya, yb);
        }
        bf16* y = (bf16*)(p.ws + WS_XN) + (rowbase + l) * D + h * 128 + e0;
        *(v4u*)y = (v4u){ow[0], ow[1], ow[2], ow[3]}; *(v4u*)(y + 8) = (v4u){ow[4], ow[5], ow[6], ow[7]};
    }
    __syncthreads();
}

__device__ __forceinline__ void p4_gla(const Params& p, LAS unsigned char* lds, int it, int wave, int lane) {
    const int c = it % NC, bh = it / NC, h = bh & 3, b = bh >> 2; const size_t rowbase = (size_t)b * T + (size_t)c * CH;
    const bf16* proj = (const bf16*)(p.ws + WS_PROJ);
    LAS bf16* qs = (LAS bf16*)lds;
    LAS bf16* ks = (LAS bf16*)(lds + 9216);
    LAS bf16* vT = (LAS bf16*)(lds + 18432);
    LAS bf16* As = (LAS bf16*)(lds + 36864);
    LAS float* hb = (LAS float*)(lds + 46080);
    LAS float* tot = (LAS float*)(lds + 79872);
    const int tid = wave * 64 + lane;
    float bc[8], gtot; gla_decay(p, rowbase, h, wave, lane, tot, bc, gtot);
    const int l0 = wave * 8;
#pragma unroll
    for (int j = 0; j < 8; ++j) {
        const size_t ro = (rowbase + l0 + j) * NPROJ;
        const float qv = bf1(proj[ro + 2048 + h * 64 + lane]) * __expf(bc[j]) * 0.125f;
        const float kv = bf1(proj[ro + 2304 + h * 64 + lane]) * __expf(-bc[j]);
        qs[(l0 + j) * TG_P + lane] = (bf16)f2bf(qv); ks[(l0 + j) * TG_P + lane] = (bf16)f2bf(kv);
    }
    stage_vT(proj, rowbase, l0, 2560 + h * 128, vT, lane);
    __syncthreads();
    const int r = lane & 15, q = lane >> 4;
    {
        const int lt = wave >> 1;
        bf16x8 af[2];
#pragma unroll
        for (int kk = 0; kk < 2; ++kk) af[kk] = *(const LAS bf16x8*)(qs + (lt * 16 + r) * TG_P + kk * 32 + q * 8);
#pragma unroll
        for (int si = 0; si < 2; ++si) {
            const int st = 2 * (wave & 1) + si;
            f32x4 acc = {0.f, 0.f, 0.f, 0.f};
            if (st <= lt) {
#pragma unroll
                for (int kk = 0; kk < 2; ++kk) { const bf16x8 bf = *(const LAS bf16x8*)(ks + (st * 16 + r) * TG_P + kk * 32 + q * 8); acc = MFMA16(af[kk], bf, acc); }
            }
            const int s = st * 16 + r;
#pragma unroll
            for (int j = 0; j < 4; ++j) { const int l = lt * 16 + q * 4 + j; As[l * KT_P + s] = (bf16)f2bf((s <= l) ? acc[j] : 0.f); }
        }
    }
    __syncthreads();
    {
        const int lt = wave & 3, eh = wave >> 2;
        const bf16* stt = (const bf16*)(p.ws + WS_UG) + (size_t)it * (128 * 64);
        bf16x8 aq[2], as_[2];
#pragma unroll
        for (int kk = 0; kk < 2; ++kk) { aq[kk] = *(const LAS bf16x8*)(qs + (lt * 16 + r) * TG_P + kk * 32 + q * 8); as_[kk] = *(const LAS bf16x8*)(As + (lt * 16 + r) * KT_P + kk * 32 + q * 8); }
#pragma unroll
        for (int et = 0; et < 4; ++et) {
            const int e = (eh * 4 + et) * 16 + r;
            f32x4 acc = {0.f, 0.f, 0.f, 0.f};
#pragma unroll
            for (int kk = 0; kk < 2; ++kk) { const bf16x8 bf = *(const LAS bf16x8*)(vT + e * KT_P + kk * 32 + q * 8); acc = MFMA16(as_[kk], bf, acc); }
#pragma unroll
            for (int kk = 0; kk < 2; ++kk) { const bf16x8 bf = *(const bf16x8*)(stt + (size_t)e * 64 + kk * 32 + q * 8); acc = MFMA16(aq[kk], bf, acc); }
#pragma unroll
            for (int j = 0; j < 4; ++j) hb[(lt * 16 + q * 4 + j) * HB_P + e] = acc[j];
        }
    }
    __syncthreads();
    {
        const int l = tid >> 3, ck = tid & 7, e0 = ck * 16;
        f32x4 x[4]; float s2 = 0.f;
#pragma unroll
        for (int i = 0; i < 4; ++i) { x[i] = *(const LAS f32x4*)(hb + l * HB_P + e0 + 4 * i); s2 += (x[i].x * x[i].x + x[i].y * x[i].y) + (x[i].z * x[i].z + x[i].w * x[i].w); }
        s2 += __shfl_xor(s2, 1); s2 += __shfl_xor(s2, 2); s2 += __shfl_xor(s2, 4);
        const float rn = 1.f / sqrtf(s2 * (1.f / 128.f) + LN_EPS);
        const bf16* gg = proj + (rowbase + l) * NPROJ + 3072 + h * 128 + e0;
        const v4u m0 = *(const v4u*)gg, m1 = *(const v4u*)(gg + 8);
        const float* gn = p.in[I_GNG] + h * 128 + e0;
        const unsigned mw[8] = {m0.x, m0.y, m0.z, m0.w, m1.x, m1.y, m1.z, m1.w};
        unsigned ow[8];
#pragma unroll
        for (int i = 0; i < 8; ++i) {
            const float xa = x[i >> 1][(i & 1) * 2], xb = x[i >> 1][(i & 1) * 2 + 1];
            ow[i] = pk2(siluf_(bflo(mw[i])) * xa * rn * gn[2 * i], siluf_(bfhi(mw[i])) * xb * rn * gn[2 * i + 1]);
        }
        bf16* y = (bf16*)(p.ws + WS_XN) + (rowbase + l) * D + 512 + h * 128 + e0;
        *(v4u*)y = (v4u){ow[0], ow[1], ow[2], ow[3]}; *(v4u*)(y + 8) = (v4u){ow[4], ow[5], ow[6], ow[7]};
    }
    __syncthreads();
}
constexpr int KS_P = 264;
constexpr int VS_P = 136;
constexpr int ATT_KS_BYTES = 128 * KS_P * 2, ATT_VS_BYTES = 256 * VS_P * 2;
static_assert(ATT_KS_BYTES + ATT_VS_BYTES <= 140 * 1024, "attention LDS");
__device__ __forceinline__ void att_stage_k(const bf16* kb, int b, int h, int hf, LAS bf16* Ks, int tid) {
#pragma unroll
    for (int i = 0; i < 8; ++i) { const int idx = tid + NTHREADS * i, m = idx >> 5, ck = idx & 31;
        const v4u v = *(const v4u*)(kb + (size_t)(b * NMEM + hf * 128 + m) * D + h * 256 + ck * 8);
        *(LAS v4u*)(Ks + m * KS_P + ck * 8) = v; }
}
__device__ __forceinline__ void att_stage_v(const bf16* vt, int b, int h, int hf, LAS bf16* Vs, int tid) {
#pragma unroll
    for (int i = 0; i < 8; ++i) { const int idx = tid + NTHREADS * i, dh = idx >> 4, ck = idx & 15;
        const v4u v = *(const v4u*)(vt + (size_t)(h * 256 + dh) * 512 + b * NMEM + hf * 128 + ck * 8);
        *(LAS v4u*)(Vs + dh * VS_P + ck * 8) = v; }
}
__device__ __forceinline__ void p7_attention(const Params& p, LAS unsigned char* lds, int unit, int wave, int lane) {
    const int rt = unit >> 2, h = unit & 3, b = rt >> 6; const int tid = wave * 64 + lane;
    const bf16* qb = (const bf16*)(p.ws + WS_QB); const bf16* kb = (const bf16*)(p.ws + WS_KB); const bf16* vt = (const bf16*)(p.ws + WS_VT);
    LAS bf16* Ks = (LAS bf16*)lds; LAS bf16* Vs = (LAS bf16*)(lds + ATT_KS_BYTES);
    const int r = lane & 15, q = lane >> 4; const size_t tok = (size_t)rt * 128 + wave * 16 + r;
    bf16x8 qf[8];
#pragma unroll
    for (int kk = 0; kk < 8; ++kk) qf[kk] = *(const bf16x8*)(qb + tok * D + h * 256 + kk * 32 + q * 8);
    f32x4 sa[16];
#pragma unroll
    for (int t = 0; t < 16; ++t) sa[t] = (f32x4){0.f, 0.f, 0.f, 0.f};
    att_stage_k(kb, b, h, 0, Ks, tid); att_stage_v(vt, b, h, 0, Vs, tid);
    __syncthreads();
#pragma unroll
    for (int mt = 0; mt < 8; ++mt)
#pragma unroll
        for (int kk = 0; kk < 8; ++kk) { const bf16x8 af = *(const LAS bf16x8*)(Ks + (mt * 16 + r) * KS_P + kk * 32 + q * 8); sa[mt] = MFMA16(af, qf[kk], sa[mt]); }
    __syncthreads();
    att_stage_k(kb, b, h, 1, Ks, tid);
    __syncthreads();
#pragma unroll
    for (int mt = 0; mt < 8; ++mt)
#pragma unroll
        for (int kk = 0; kk < 8; ++kk) { const bf16x8 af = *(const LAS bf16x8*)(Ks + (mt * 16 + r) * KS_P + kk * 32 + q * 8); sa[8 + mt] = MFMA16(af, qf[kk], sa[8 + mt]); }
    float mx = -3.0e38f;
#pragma unroll
    for (int t = 0; t < 16; ++t) mx = fmaxf(mx, fmaxf(fmaxf(sa[t][0], sa[t][1]), fmaxf(sa[t][2], sa[t][3])));
    mx = fmaxf(mx, __shfl_xor(mx, 16)); mx = fmaxf(mx, __shfl_xor(mx, 32));
    float sum = 0.f;
#pragma unroll
    for (int t = 0; t < 16; ++t)
#pragma unroll
        for (int j = 0; j < 4; ++j) { const float e = __expf(sa[t][j] - mx); sa[t][j] = e; sum += e; }
    sum += __shfl_xor(sum, 16); sum += __shfl_xor(sum, 32);
    const float inv = 1.f / sum;
    bf16x8 pf[8];
#pragma unroll
    for (int u = 0; u < 8; ++u) { v4u w; w.x = pk2(sa[2 * u][0], sa[2 * u][1]); w.y = pk2(sa[2 * u][2], sa[2 * u][3]); w.z = pk2(sa[2 * u + 1][0], sa[2 * u + 1][1]); w.w = pk2(sa[2 * u + 1][2], sa[2 * u + 1][3]);
        pf[u] = __builtin_bit_cast(bf16x8, w); }
    f32x4 oa[16];
#pragma unroll
    for (int t = 0; t < 16; ++t) oa[t] = (f32x4){0.f, 0.f, 0.f, 0.f};
#pragma unroll
    for (int hf = 0; hf < 2; ++hf) {
        if (hf == 1) { __syncthreads(); att_stage_v(vt, b, h, 1, Vs, tid); __syncthreads(); }
#pragma unroll
        for (int dt = 0; dt < 16; ++dt)
#pragma unroll
            for (int uu = 0; uu < 4; ++uu) {
                const int u = hf * 4 + uu;
                const LAS bf16* vr = Vs + (dt * 16 + r) * VS_P + (2 * uu) * 16 + q * 4;
                const v2u lo = *(const LAS v2u*)vr, hi = *(const LAS v2u*)(vr + 16);
                const v4u w = {lo.x, lo.y, hi.x, hi.y};
                oa[dt] = MFMA16(__builtin_bit_cast(bf16x8, w), pf[u], oa[dt]);
            }
    }
    bf16* ob = (bf16*)(p.ws + WS_OB) + tok * D + h * 256;
#pragma unroll
    for (int dt = 0; dt < 16; ++dt) { v2u o; o.x = pk2(oa[dt][0] * inv, oa[dt][1] * inv); o.y = pk2(oa[dt][2] * inv, oa[dt][3] * inv); *(v2u*)(ob + dt * 16 + q * 4) = o; }
    __syncthreads();
}

#define XB_TMO      128
#define XB_XCNT(j)  (256  + 64 * (j))
#define XB_XSUB(j)  (1280 + 64 * (j))
#define XB_XGEN(j)  (2304 + 64 * (j))
#define XB_TOP      3328
#define XB_TOPGEN   3392
#define XCD_BAR_WORDS 3456
#define XB_SPIN_CAP (1u << 18)

__device__ __forceinline__ unsigned xb_ld(unsigned* p)              { return __hip_atomic_load(p, __ATOMIC_RELAXED, __HIP_MEMORY_SCOPE_AGENT); }
__device__ __forceinline__ unsigned xb_add(unsigned* p, unsigned v) { return __hip_atomic_fetch_add(p, v, __ATOMIC_RELAXED, __HIP_MEMORY_SCOPE_AGENT); }
__device__ __forceinline__ unsigned xb_xcc_id() { return (unsigned)__builtin_amdgcn_s_getreg((3 << 11) | 20) & 0xFu; }
#define XB_SPIN(cond, bar) do { unsigned _sp = 0; while (cond) { __builtin_amdgcn_s_sleep(1); \
    if ((++_sp & 255u) == 0u) { if (xb_ld(&(bar)[XB_TMO])) break; if (_sp > XB_SPIN_CAP) { atomicAdd(&(bar)[XB_TMO], 1u); break; } } } } while (0)

struct XcdBarrier {
    unsigned* bar; unsigned x;
    volatile LAS unsigned* st;
};

__device__ __forceinline__ XcdBarrier xcd_barrier_post(unsigned* bar, volatile LAS unsigned* st) {
    XcdBarrier b; b.bar = bar; b.x = xb_xcc_id(); b.st = st;
    if (threadIdx.x == 0) (void)xb_add(&bar[XB_XCNT(b.x)], 1u);
    return b;
}
__device__ __forceinline__ void xcd_barrier_complete(unsigned* bar, unsigned x, unsigned& nloc, unsigned& nx) {
    const unsigned G = gridDim.x * gridDim.y * gridDim.z;
    unsigned sum, cnt, mine, sp = 0u;
    for (;;) {
        sum = 0u; cnt = 0u; mine = 0u;
#pragma unroll
        for (unsigned j = 0; j < 16; ++j) { const unsigned c = xb_ld(&bar[XB_XCNT(j)]); sum += c; cnt += (c > 0u) ? 1u : 0u; mine = (j == x) ? c : mine; }
        if (sum == G) break;
        __builtin_amdgcn_s_sleep(1);
        if ((++sp & 255u) == 0u) { if (xb_ld(&bar[XB_TMO])) break; if (sp > XB_SPIN_CAP) { atomicAdd(&bar[XB_TMO], 1u); break; } }
    }
    nloc = mine > 0u ? mine : 1u; nx = cnt > 0u ? cnt : 1u;
}

__device__ __forceinline__ void xcd_barrier(const XcdBarrier& b) {
    asm volatile("s_waitcnt vmcnt(0)" ::: "memory");
    __syncthreads();
    if (threadIdx.x == 0) {
        unsigned* bar = b.bar;
        __builtin_amdgcn_s_waitcnt(0);
        unsigned nloc = b.st[0], nx = b.st[1];
        if (nloc == 0u) { xcd_barrier_complete(bar, b.x, nloc, nx); b.st[0] = nloc; b.st[1] = nx; }
        const unsigned old = xb_add(&bar[XB_XSUB(b.x)], 1u);
        const unsigned gen = old / nloc;
        if (old + 1u == (gen + 1u) * nloc) {
            __builtin_amdgcn_fence(__ATOMIC_RELEASE, "agent");
            asm volatile("s_waitcnt vmcnt(0)" ::: "memory");
            const unsigned og = xb_add(&bar[XB_TOP], 1u);
            const unsigned tg = og / nx;
            if (og + 1u == (tg + 1u) * nx) xb_add(&bar[XB_TOPGEN], 1u);
            else XB_SPIN(xb_ld(&bar[XB_TOPGEN]) == tg, bar);
            __builtin_amdgcn_fence(__ATOMIC_ACQUIRE, "agent");
            xb_add(&bar[XB_XGEN(b.x)], 1u);
            asm volatile("s_waitcnt vmcnt(0)" ::: "memory");
        } else {
            XB_SPIN(xb_ld(&bar[XB_XGEN(b.x)]) == gen, bar);
            __builtin_amdgcn_fence(__ATOMIC_ACQUIRE, "agent");
            asm volatile("s_waitcnt vmcnt(0)" ::: "memory");
        }
    }
    __syncthreads();
}

#ifndef USE_CG
#define USE_CG 0
#endif
__global__ void __launch_bounds__(NTHREADS, 2) hymba_fwd(Params p) {
    extern __shared__ __attribute__((aligned(16))) unsigned char lds_raw[];
    LAS unsigned char* lds = (LAS unsigned char*)lds_raw;
#if USE_CG
    cg::grid_group grid = cg::this_grid();
#endif
    const int tid = threadIdx.x, lane = tid & 63, wave = __builtin_amdgcn_readfirstlane(tid >> 6);
    const int G = gridDim.x, bx = blockIdx.x;
    const int gw = bx * NWAVES + wave, NGW = G * NWAVES;
    unsigned char* ws = p.ws;
#if USE_CG
#define GRID_BAR() grid.sync()
#else
    volatile LAS unsigned* MISC = (volatile LAS unsigned*)(lds + MISC_OFF);
    if (tid < 32) MISC[tid] = 0u;
    __syncthreads();
    XcdBarrier bar = xcd_barrier_post((unsigned*)(ws + WS_CTL) + 4096, MISC + 8);
#define GRID_BAR() xcd_barrier(bar)
#endif

    p0_prologue(p, lds, gw, NGW, wave, lane);
    GRID_BAR();
    {
        pg8::Gemm g{(const pg8::bf16_t*)(ws + WS_ROWBUF), (const pg8::bf16_t*)(ws + WS_ROWBUF), M, 3840, D};
        pg8::ProjOrder S; S.init(G, bx);
        pg8::EpiProj E{(pg8::bf16_t*)(ws + WS_PROJ), (float*)(ws + WS_GATES), (pg8::bf16_t*)(ws + WS_KB), (pg8::bf16_t*)(ws + WS_VT)};
        pg8::gemm_phase<pg8::EpiProj, pg8::ProjOrder, true, true>(lds, g, S, E);
    }
    GRID_BAR();
    for (int i = bx; i < 2048; i += G) { if (i < 1024) p2_mlstm(p, lds, i, wave, lane); else p2_gla(p, lds, i - 1024, wave, lane); }
    GRID_BAR();
    p3_scan(p, gw, NGW, lane);
    GRID_BAR();
    for (int i = bx; i < 2048; i += G) { if (i < 1024) p4_mlstm(p, lds, i, wave, lane); else p4_gla(p, lds, i - 1024, wave, lane); }
    GRID_BAR();
    {
        pg8::Gemm g{(const pg8::bf16_t*)(ws + WS_XN), (const pg8::bf16_t*)(ws + WS_WOUT), M, D, D};
        pg8::StaticOrder S; S.init(M, D, G, bx);
        pg8::EpiResF32 E{p.out, p.out, D, ALPHA};
        pg8::gemm_phase<pg8::EpiResF32, pg8::StaticOrder, true, true>(lds, g, S, E);
    }
    GRID_BAR();
    ln_pass(p.out, p.out, (bf16*)(ws + WS_XN), p.in[I_LN1G], p.in[I_LN1B], gw, NGW, lane);
    GRID_BAR();
    {
        pg8::Gemm g{(const pg8::bf16_t*)(ws + WS_XN), (const pg8::bf16_t*)(ws + WS_WQ), M, D, D};
        pg8::StaticOrder S; S.init(M, D, G, bx);
        pg8::EpiAct<0> E{(pg8::bf16_t*)(ws + WS_QB), D, 0.0625f};
        pg8::gemm_phase<pg8::EpiAct<0>, pg8::StaticOrder, true, true>(lds, g, S, E);
    }
    GRID_BAR();
    for (int u = bx; u < 512; u += G) p7_attention(p, lds, u, wave, lane);
    GRID_BAR();
    {
        pg8::Gemm g{(const pg8::bf16_t*)(ws + WS_OB), (const pg8::bf16_t*)(ws + WS_WXO), M, D, D};
        pg8::StaticOrder S; S.init(M, D, G, bx);
        pg8::EpiResF32 E{p.out, p.out, D, ALPHA};
        pg8::gemm_phase<pg8::EpiResF32, pg8::StaticOrder, true, true>(lds, g, S, E);
    }
    GRID_BAR();
    ln_pass(p.out, p.out, (bf16*)(ws + WS_XN), p.in[I_LN2G], p.in[I_LN2B], gw, NGW, lane);
    GRID_BAR();
    {
        pg8::Gemm g{(const pg8::bf16_t*)(ws + WS_XN), (const pg8::bf16_t*)(ws + WS_W1), M, FF, D};
        pg8::StaticOrder S; S.init(M, FF, G, bx);
        pg8::EpiAct<2> E{(pg8::bf16_t*)(ws + WS_HB), FF, 1.f};
        pg8::gemm_phase<pg8::EpiAct<2>, pg8::StaticOrder, true, true>(lds, g, S, E);
    }
    GRID_BAR();
    {
        pg8::Gemm g{(const pg8::bf16_t*)(ws + WS_HB), (const pg8::bf16_t*)(ws + WS_W2), M, D, FF};
        pg8::StaticOrder S; S.init(M, D, G, bx);
        pg8::EpiResF32 E{p.out, p.out, D, ALPHA};
        pg8::gemm_phase<pg8::EpiResF32, pg8::StaticOrder, true, true>(lds, g, S, E);
    }
    GRID_BAR();
    ln_pass(p.out, p.out, nullptr, p.in[I_LN3G], p.in[I_LN3B], gw, NGW, lane);
}

extern "C" void kernel_launch(void* const* d_in, const int* in_sizes, int n_in, void* d_out, int out_size, void* d_ws, size_t ws_size, hipStream_t stream) {
    static int grid = 0;
    if (grid == 0) {
        if (n_in != 26 || out_size != M * D || ws_size < WS_END) { fprintf(stderr, "kernel_launch: unexpected shapes n_in %d out %d ws %zu\n", n_in, out_size, ws_size); grid = -1; return; }
        int dev = 0, cus = 0, per_cu = 0;
        (void)hipGetDevice(&dev); (void)hipDeviceGetAttribute(&cus, hipDeviceAttributeMultiprocessorCount, dev);
        (void)hipFuncSetAttribute((const void*)hymba_fwd, hipFuncAttributeMaxDynamicSharedMemorySize, LDS_BYTES);
        (void)hipOccupancyMaxActiveBlocksPerMultiprocessor(&per_cu, (const void*)hymba_fwd, NTHREADS, LDS_BYTES);
        if (per_cu < 1) { fprintf(stderr, "kernel_launch: occupancy query says %d blocks per CU\n", per_cu); per_cu = 1; }
        (void)hipGetLastError();
        grid = cus;
    }
    if (grid < 0) return;
    if (hipMemsetAsync((char*)d_ws + WS_CTL, 0, 65536, stream) != hipSuccess) { fprintf(stderr, "kernel_launch: memset failed\n"); return; }
    Params p{};
    for (int i = 0; i < 26; ++i) p.in[i] = (const float*)d_in[i];
    p.out = (float*)d_out; p.ws = (unsigned char*)d_ws;
    void* args[] = {&p};
    hipError_t e = hipLaunchCooperativeKernel((void*)hymba_fwd, dim3(grid), dim3(NTHREADS), args, LDS_BYTES, stream);
    if (e != hipSuccess) fprintf(stderr, "cooperative launch failed: %s (grid %d)\n", hipGetErrorString(e), grid);
}
```
